# Optimizing an MI355X kernel written in HIP

```python
import math
import jax
import jax.numpy as jnp
from jax import lax
import numpy as np

D_MODEL = 1024
BATCH = 4
SEQ = 8192
DEPTH = 1

GRID_W = 64
CTX_LEN = 256
N_MOD = 6
MLSTM_HEADS = 4
MLSTM_DQK = 128
MLSTM_DV = 256
MLSTM_CHUNK = 64
CONV_K = 5
DIFF_HEADS = 8
DIFF_HEAD_DIM = 64
Q_BLOCK = 128
ROPE_BASE = 10000.0
ROPE_AXIS_DIM = DIFF_HEAD_DIM // 2
ROPE_FREQS = ROPE_AXIS_DIM // 2
FFN_HIDDEN = -(-8 * D_MODEL // (3 * 256)) * 256

M_QK_W = MLSTM_HEADS * MLSTM_DQK
M_V_W = MLSTM_HEADS * MLSTM_DV
M_GATES = 4 * MLSTM_HEADS
DA_W = DIFF_HEADS * 2 * DIFF_HEAD_DIM
IN_SIZES = (M_QK_W, M_QK_W, M_V_W, M_V_W, M_GATES, DA_W, DA_W, DA_W, D_MODEL, D_MODEL)
IN_WIDTH = sum(IN_SIZES)
IN_SPLIT_POINTS = tuple(int(s) for s in np.cumsum(IN_SIZES)[:-1])

kernel_name = 'hybrid_mlstm_diffattn_dit_block'


def rms_norm(x, g, eps=1e-6):
    xf = x.astype(jnp.float32)
    y = xf * lax.rsqrt(jnp.mean(xf * xf, axis=-1, keepdims=True) + eps)
    return (y * g.astype(jnp.float32)).astype(x.dtype)


def modulated_norm(x, g, shift, scale):
    return rms_norm(x, g) * (1 + scale) + shift


def centred_dwconv(x, w, b):
    y = lax.conv_general_dilated(x, w[:, None, :], (1,), [(CONV_K // 2, CONV_K // 2)],
                                 dimension_numbers=('NWC', 'WIO', 'NWC'),
                                 feature_group_count=x.shape[-1])
    return y + b


def to_heads(a, n_heads):
    B, T, _ = a.shape
    return a.reshape(B, T, n_heads, -1).transpose(0, 2, 1, 3)


def flip_t(a):
    return jnp.flip(a, axis=2)


def axial_rope_tables(n_tokens):
    rows = n_tokens // GRID_W
    row = jnp.repeat(jnp.arange(rows, dtype=jnp.float32), GRID_W)
    col = jnp.tile(jnp.arange(GRID_W, dtype=jnp.float32), rows)
    inv = ROPE_BASE ** (-jnp.arange(ROPE_FREQS, dtype=jnp.float32) / ROPE_FREQS)
    ang = jnp.concatenate([row[:, None] * inv, col[:, None] * inv], axis=-1)
    return jnp.cos(ang), jnp.sin(ang)


def rotate_pairs(xh, cos, sin):
    x1, x2 = xh[..., :ROPE_FREQS], xh[..., ROPE_FREQS:]
    return jnp.concatenate([x1 * cos - x2 * sin, x2 * cos + x1 * sin], axis=-1)


def apply_axial_rope(x, cos, sin):
    xf = x.astype(jnp.float32)
    y = jnp.concatenate([
        rotate_pairs(xf[..., :ROPE_AXIS_DIM], cos[:, :ROPE_FREQS], sin[:, :ROPE_FREQS]),
        rotate_pairs(xf[..., ROPE_AXIS_DIM:], cos[:, ROPE_FREQS:], sin[:, ROPE_FREQS:])], axis=-1)
    return y.astype(x.dtype)


def mlstm_chunkwise(q, k, v, ig, lf, C0, n0, m0):
    B, H, T, DK = q.shape
    DV = v.shape[-1]
    L = MLSTM_CHUNK
    NC = T // L
    lower = jnp.tril(jnp.ones((L, L), dtype=bool))

    def chunks(a):
        return jnp.moveaxis(a.reshape(a.shape[:2] + (NC, L) + a.shape[3:]), 2, 0)

    def step(carry, inp):
        C, n, m = carry
        qc, kc, vc, igc, lfc = inp
        b = jnp.cumsum(lfc, axis=-1)
        logD = jnp.where(lower, b[..., :, None] - b[..., None, :] + igc[..., None, :], -jnp.inf)
        m_inter = b + m[..., None]
        m_j = jnp.maximum(m_inter, jnp.max(logD, axis=-1))
        dmat = jnp.exp(logD - m_j[..., None])
        inter = jnp.exp(m_inter - m_j)
        s = jnp.einsum('bhjd,bhsd->bhjs', qc, kc) * dmat
        num = jnp.einsum('bhjs,bhse->bhje', s, vc) + inter[..., None] * jnp.einsum('bhjd,bhde->bhje', qc, C)
        den = jnp.sum(s, axis=-1) + inter * jnp.einsum('bhjd,bhd->bhj', qc, n)
        h = num / jnp.maximum(jnp.abs(den), jnp.exp(-m_j))[..., None]
        bL = b[..., -1]
        logw = bL[..., None] - b + igc
        m_new = jnp.maximum(bL + m, jnp.max(logw, axis=-1))
        w = jnp.exp(logw - m_new[..., None])
        dec = jnp.exp(bL + m - m_new)
        C_new = dec[..., None, None] * C + jnp.einsum('bhs,bhsd,bhse->bhde', w, kc, vc)
        n_new = dec[..., None] * n + jnp.einsum('bhs,bhsd->bhd', w, kc)
        return (C_new, n_new, m_new), h

    state, h = lax.scan(step, (C0, n0, m0), (chunks(q), chunks(k), chunks(v), chunks(ig), chunks(lf)))
    h = jnp.moveaxis(h, 0, 2).reshape(B, H, T, DV)
    return h, state


def project_stream(xn, w_in, b_gate, conv_w, conv_b, q_norm, k_norm):
    f32 = jnp.float32
    p = xn @ w_in
    mq, mk, mv, mo, mg, dq, dk, dv, ga, gb = jnp.split(p, IN_SPLIT_POINTS, axis=-1)
    qk = jax.nn.silu(centred_dwconv(jnp.concatenate([mq, mk], axis=-1), conv_w, conv_b))
    mq = to_heads(qk[..., :M_QK_W], MLSTM_HEADS).astype(f32) * MLSTM_DQK ** -0.5
    mk = to_heads(qk[..., M_QK_W:], MLSTM_HEADS).astype(f32)
    mv = to_heads(mv, MLSTM_HEADS).astype(f32)
    g = (mg + b_gate).astype(f32)
    B, T, _ = g.shape
    g = g.reshape(B, T, 4, MLSTM_HEADS).transpose(2, 0, 3, 1)
    gates = (g[0], jax.nn.log_sigmoid(g[1]), g[2], jax.nn.log_sigmoid(g[3]))
    dq = to_heads(dq, DIFF_HEADS)
    dk = to_heads(dk, DIFF_HEADS)
    q1 = rms_norm(dq[..., :DIFF_HEAD_DIM], q_norm)
    q2 = rms_norm(dq[..., DIFF_HEAD_DIM:], q_norm)
    k1 = rms_norm(dk[..., :DIFF_HEAD_DIM], k_norm)
    k2 = rms_norm(dk[..., DIFF_HEAD_DIM:], k_norm)
    dv = to_heads(dv, DIFF_HEADS)
    return mq, mk, mv, mo, gates, q1, q2, k1, k2, dv, ga, gb


def mlstm_output(h, o, g):
    B, H, T, DV = h.shape
    hn = rms_norm(h.transpose(0, 2, 1, 3), g.reshape(H, DV)).reshape(B, T, H * DV)
    return jax.nn.sigmoid(o.astype(jnp.float32)) * hn


def diff_weights(q1, q2, k1, k2, lam):
    s1 = jnp.einsum('bhqd,bhkd->bhqk', q1, k1, preferred_element_type=jnp.float32)
    s2 = jnp.einsum('bhqd,bhkd->bhqk', q2, k2, preferred_element_type=jnp.float32)
    return jax.nn.softmax(s1, axis=-1) - lam * jax.nn.softmax(s2, axis=-1)


def diff_attention_blocks(q1, q2, k1, k2, v, lam):
    B, H, T, d = q1.shape
    nb = T // Q_BLOCK
    vf = v.astype(jnp.float32)

    def blocks(a):
        return jnp.moveaxis(a.reshape(B, H, nb, Q_BLOCK, d), 2, 0)

    def one_block(qs):
        w = diff_weights(qs[0], qs[1], k1, k2, lam)
        return jnp.einsum('bhqk,bhke->bhqe', w, vf)

    out = lax.map(one_block, (blocks(q1), blocks(q2)))
    return jnp.moveaxis(out, 0, 2).reshape(B, H, T, v.shape[-1])


def diff_output(o, g, lam_init):
    B, H, T, E = o.shape
    return (rms_norm(o, g) * (1 - lam_init)).transpose(0, 2, 1, 3).reshape(B, T, H * E)


def merge_branches(hA, hB, ga, gb, w_a, w_b, w_o):
    y = jax.nn.sigmoid(ga) * (hA @ w_a) + jax.nn.sigmoid(gb) * (hB @ w_b)
    return y @ w_o


def swiglu_ffn(xn, w_in, w_out):
    a, b = jnp.split(xn @ w_in, 2, axis=-1)
    return (jax.nn.silu(a) * b) @ w_out


def setup_inputs(seed: int = 0) -> dict:
    key = jax.random.key(seed)
    ks = jax.random.split(key, 32)

    def nrm(k, shape, s):
        return jax.random.normal(k, shape, jnp.float32) * s

    fg_base = jnp.linspace(3.0, 6.0, MLSTM_HEADS, dtype=jnp.float32)[None, :]
    b_gate = jnp.concatenate([
        nrm(ks[9], (DEPTH, MLSTM_HEADS), 0.1),
        fg_base + nrm(ks[10], (DEPTH, MLSTM_HEADS), 0.1),
        nrm(ks[11], (DEPTH, MLSTM_HEADS), 0.1),
        fg_base + nrm(ks[12], (DEPTH, MLSTM_HEADS), 0.1)], axis=-1)
    return {
        'x': nrm(ks[0], (BATCH, SEQ, D_MODEL), 1.0),
        'c': nrm(ks[1], (BATCH, D_MODEL), 1.0),
        'ctx': nrm(ks[2], (BATCH, CTX_LEN, D_MODEL), 1.0),
        'c_ctx': nrm(ks[3], (D_MODEL,), 1.0),
        'w_mod': nrm(ks[4], (DEPTH, D_MODEL, N_MOD * D_MODEL), D_MODEL ** -0.5),
        'b_mod': nrm(ks[5], (DEPTH, N_MOD * D_MODEL), 0.02),
        'norm1': 1.0 + nrm(ks[6], (DEPTH, D_MODEL), 0.02),
        'norm2': 1.0 + nrm(ks[7], (DEPTH, D_MODEL), 0.02),
        'w_in': nrm(ks[8], (DEPTH, D_MODEL, IN_WIDTH), D_MODEL ** -0.5),
        'b_gate': b_gate,
        'conv_w': nrm(ks[13], (DEPTH, CONV_K, 2 * M_QK_W), CONV_K ** -0.5),
        'conv_b': nrm(ks[14], (DEPTH, 2 * M_QK_W), 0.02),
        'mlstm_norm': 1.0 + nrm(ks[15], (DEPTH, M_V_W), 0.02),
        'q_norm': 1.0 + nrm(ks[16], (DEPTH, DIFF_HEAD_DIM), 0.02),
        'k_norm': 1.0 + nrm(ks[17], (DEPTH, DIFF_HEAD_DIM), 0.02),
        'lam_vecs': nrm(ks[18], (DEPTH, 4, DIFF_HEAD_DIM), 0.1),
        'diff_norm': 1.0 + nrm(ks[19], (DEPTH, 2 * DIFF_HEAD_DIM), 0.02),
        'w_branch_a': nrm(ks[20], (DEPTH, M_V_W, D_MODEL), M_V_W ** -0.5),
        'w_branch_b': nrm(ks[21], (DEPTH, DA_W, D_MODEL), DA_W ** -0.5),
        'w_out': nrm(ks[22], (DEPTH, D_MODEL, D_MODEL), D_MODEL ** -0.5),
        'w_ffn_in': nrm(ks[23], (DEPTH, D_MODEL, 2 * FFN_HIDDEN), D_MODEL ** -0.5),
        'w_ffn_out': nrm(ks[24], (DEPTH, FFN_HIDDEN, D_MODEL), FFN_HIDDEN ** -0.5),
    }


def reference(x, c, ctx, c_ctx, w_mod, b_mod, norm1, norm2, w_in, b_gate, conv_w, conv_b, mlstm_norm,
              q_norm, k_norm, lam_vecs, diff_norm, w_branch_a, w_branch_b, w_out, w_ffn_in, w_ffn_out):
    f32 = jnp.float32
    B, S, _ = x.shape
    cos, sin = axial_rope_tables(S)
    scale_q = DIFF_HEAD_DIM ** -0.5
    for l in range(DEPTH):
        last = l == DEPTH - 1
        mod = jax.nn.silu(c) @ w_mod[l] + b_mod[l]
        sh1, sc1, g1, sh2, sc2, g2 = [m[:, None, :] for m in jnp.split(mod, N_MOD, axis=-1)]
        mod_c = jax.nn.silu(c_ctx) @ w_mod[l] + b_mod[l]
        csh1, csc1, cg1, csh2, csc2, cg2 = jnp.split(mod_c, N_MOD)

        xn = modulated_norm(x, norm1[l], sh1, sc1)
        cn = modulated_norm(ctx, norm1[l], csh1, csc1)
        (mq, mk, mv, mo, (ig_f, lf_f, ig_b, lf_b), q1, q2, k1, k2, dv, ga, gb) = project_stream(
            xn, w_in[l], b_gate[l], conv_w[l], conv_b[l], q_norm[l], k_norm[l])
        (cmq, cmk, cmv, cmo, (cig_f, clf_f, cig_b, clf_b), cq1, cq2, ck1, ck2, cdv, cga, cgb) = project_stream(
            cn, w_in[l], b_gate[l], conv_w[l], conv_b[l], q_norm[l], k_norm[l])

        zero = (jnp.zeros((B, MLSTM_HEADS, MLSTM_DQK, MLSTM_DV), f32),
                jnp.zeros((B, MLSTM_HEADS, MLSTM_DQK), f32),
                jnp.zeros((B, MLSTM_HEADS), f32))
        hc_f, st_f = mlstm_chunkwise(cmq, cmk, cmv, cig_f, clf_f, *zero)
        hc_b, st_b = mlstm_chunkwise(flip_t(cmq), flip_t(cmk), flip_t(cmv), flip_t(cig_b), flip_t(clf_b), *zero)
        h_f, _ = mlstm_chunkwise(mq, mk, mv, ig_f, lf_f, *st_f)
        h_b, _ = mlstm_chunkwise(flip_t(mq), flip_t(mk), flip_t(mv), flip_t(ig_b), flip_t(lf_b), *st_b)
        hA = mlstm_output(h_f + flip_t(h_b), mo, mlstm_norm[l])

        lam_init = 0.8 - 0.6 * math.exp(-0.3 * l)
        lv = lam_vecs[l].astype(f32)
        lam = jnp.exp(jnp.sum(lv[0] * lv[1])) - jnp.exp(jnp.sum(lv[2] * lv[3])) + lam_init
        q1r = apply_axial_rope(q1, cos, sin) * scale_q
        q2r = apply_axial_rope(q2, cos, sin) * scale_q
        k1_all = jnp.concatenate([apply_axial_rope(k1, cos, sin), ck1], axis=2)
        k2_all = jnp.concatenate([apply_axial_rope(k2, cos, sin), ck2], axis=2)
        v_all = jnp.concatenate([dv, cdv], axis=2)
        o = diff_attention_blocks(q1r, q2r, k1_all, k2_all, v_all, lam)
        hB = diff_output(o, diff_norm[l], lam_init)

        y = merge_branches(hA, hB, ga, gb, w_branch_a[l], w_branch_b[l], w_out[l])
        x = x + (g1 * y).astype(x.dtype)
        x = x + (g2 * swiglu_ffn(modulated_norm(x, norm2[l], sh2, sc2), w_ffn_in[l], w_ffn_out[l])).astype(x.dtype)

        if not last:
            hcA = mlstm_output(hc_f + flip_t(hc_b), cmo, mlstm_norm[l])
            wc = diff_weights(cq1 * scale_q, cq2 * scale_q, ck1, ck2, lam)
            hcB = diff_output(jnp.einsum('bhqk,bhke->bhqe', wc, cdv.astype(f32)), diff_norm[l], lam_init)
            yc = merge_branches(hcA, hcB, cga, cgb, w_branch_a[l], w_branch_b[l], w_out[l])
            ctx = ctx + (cg1 * yc).astype(ctx.dtype)
            ctx = ctx + (cg2 * swiglu_ffn(modulated_norm(ctx, norm2[l], csh2, csc2), w_ffn_in[l], w_ffn_out[l])).astype(ctx.dtype)
    return x
```

```cpp
#include <hip/hip_runtime.h>
#include <hip/hip_cooperative_groups.h>
#include <cstdio>
#include <cstdint>
namespace cg = cooperative_groups;

#define DI __device__ __forceinline__
typedef unsigned short bf16_t;
typedef short bf16x8 __attribute__((ext_vector_type(8)));
typedef short bf16x4 __attribute__((ext_vector_type(4)));
typedef float f32x2 __attribute__((ext_vector_type(2)));
typedef float f32x4 __attribute__((ext_vector_type(4)));
typedef float f32x16 __attribute__((ext_vector_type(16)));
typedef unsigned u32x2 __attribute__((ext_vector_type(2)));
typedef unsigned u32x4 __attribute__((ext_vector_type(4)));
typedef __bf16 bfv2 __attribute__((ext_vector_type(2)));

constexpr int DM = 1024, NB = 4, SEQ = 8192, CTXL = 256, TB = SEQ + CTXL;
constexpr int PW = 8192;
constexpr int PLD = PW + 64;
constexpr int NWIN = 8448;
constexpr int FH = 2816;
constexpr int NSTEP = 33;
constexpr int STROWS = 288;
constexpr int SMEM_BYTES = 147456;

struct Params {
  const float *x, *c, *ctx, *c_ctx, *w_mod, *b_mod, *norm1, *norm2, *w_in, *b_gate, *conv_w, *conv_b, *mlstm_norm,
      *q_norm, *k_norm, *lam_vecs, *diff_norm, *w_a, *w_b, *w_out, *w_ffn_in, *w_ffn_out;
  float* out;
  bf16_t *WinT, *WaT, *WbT, *WoT, *WfiT, *WfoT;
  float *mod, *rope;
  bf16_t *xn, *P;
  float* gates;
  bf16_t *Qm, *Km, *KTm, *VTm, *Qd, *Kd, *VTd;
  float *scal, *stepsc;
  bf16_t *ST, *hA, *hB, *y, *xn2, *hid;
  unsigned* bar;
};

DI unsigned pk2(float a, float b) { f32x2 v = {a, b}; return __builtin_bit_cast(unsigned, __builtin_convertvector(v, bfv2)); }
DI bf16_t f2bf(float a) { return (bf16_t)(pk2(a, 0.f) & 0xffffu); }
DI float bf_lo(unsigned u) { return __uint_as_float(u << 16); }
DI float bf_hi(unsigned u) { return __uint_as_float(u & 0xffff0000u); }
DI float bf2f(bf16_t u) { return __uint_as_float(((unsigned)u) << 16); }
DI float siluf(float x) { return x * __builtin_amdgcn_rcpf(1.f + __expf(-x)); }
DI float sigmf(float x) { return __builtin_amdgcn_rcpf(1.f + __expf(-x)); }
DI f32x16 zero16() { f32x16 z; for (int i = 0; i < 16; ++i) z[i] = 0.f; return z; }
DI f32x4 zero4() { f32x4 z = {0.f, 0.f, 0.f, 0.f}; return z; }
#define MFMA32(a, b, c) __builtin_amdgcn_mfma_f32_32x32x16_bf16((a), (b), (c), 0, 0, 0)
#define MFMA16(a, b, c) __builtin_amdgcn_mfma_f32_16x16x32_bf16((a), (b), (c), 0, 0, 0)

DI bf16x8 pack8(const f32x16& x, int s) {
  u32x4 p;
  p[0] = pk2(x[8 * s + 0], x[8 * s + 1]); p[1] = pk2(x[8 * s + 2], x[8 * s + 3]);
  p[2] = pk2(x[8 * s + 4], x[8 * s + 5]); p[3] = pk2(x[8 * s + 6], x[8 * s + 7]);
  return __builtin_bit_cast(bf16x8, p);
}
DI bf16x8 cat4(u32x2 a, u32x2 b) { u32x4 p = {a[0], a[1], b[0], b[1]}; return __builtin_bit_cast(bf16x8, p); }

DI int srccol_win(int j) { if (j < 3072) return j; if (j < 8192) return j + 16; if (j < 8208) return 3072 + (j - 8192); return -1; }
DI int srccol_ffi(int r) { const int g = r >> 6, rr = r & 63; return rr < 32 ? g * 32 + rr : FH + g * 32 + (rr - 32); }

DI void wt_tile(const float* __restrict__ src, int ldsrc, int K, bf16_t* __restrict__ dst, int n0, int k0, int mode, bf16_t* sm) {
  const int t = threadIdx.x, nl = t & 63, kb = t >> 6;
  const int j = n0 + nl;
  const int sc = mode == 1 ? srccol_win(j) : (mode == 2 ? srccol_ffi(j) : j);
#pragma unroll 4
  for (int pss = 0; pss < 16; ++pss) {
    const int k = kb + 4 * pss;
    const float v = sc >= 0 ? src[(size_t)(k0 + k) * ldsrc + sc] : 0.f;
    sm[k * 66 + nl] = f2bf(v);
  }
  __syncthreads();
  const int n = t >> 2, ks = (t & 3) * 16;
  unsigned w[8];
#pragma unroll
  for (int i = 0; i < 8; ++i) w[i] = (unsigned)sm[(ks + 2 * i) * 66 + n] | ((unsigned)sm[(ks + 2 * i + 1) * 66 + n] << 16);
  u32x4* d = (u32x4*)(dst + (size_t)(n0 + n) * K + k0 + ks);
  d[0] = (u32x4){w[0], w[1], w[2], w[3]};
  d[1] = (u32x4){w[4], w[5], w[6], w[7]};
  __syncthreads();
}

DI void mod_task(const Params& p, int task, float* smf) {
  const int tid = threadIdx.x;
  for (int idx = tid; idx < 5 * 1024; idx += 256) {
    const int r = idx >> 10, k = idx & 1023;
    const float v = r < 4 ? p.c[r * 1024 + k] : p.c_ctx[k];
    smf[idx] = siluf(v);
  }
  __syncthreads();
  const int col = tid & 31, kg = tid >> 5, n = task * 32 + col;
  float acc[5] = {0.f, 0.f, 0.f, 0.f, 0.f};
  for (int k = kg * 128; k < kg * 128 + 128; ++k) {
    const float w = p.w_mod[(size_t)k * 6144 + n];
#pragma unroll
    for (int r = 0; r < 5; ++r) acc[r] += smf[r * 1024 + k] * w;
  }
  float* red = smf + 5120;
#pragma unroll
  for (int r = 0; r < 5; ++r) red[(kg * 32 + col) * 5 + r] = acc[r];
  __syncthreads();
  if (tid < 160) {
    const int r = tid >> 5, cc = tid & 31;
    float s = 0.f;
    for (int g = 0; g < 8; ++g) s += red[(g * 32 + cc) * 5 + r];
    p.mod[r * 6144 + task * 32 + cc] = s + p.b_mod[task * 32 + cc];
  }
  __syncthreads();
}

DI void phase0(const Params& p, int vb, int G, unsigned char* smem) {
  const int nWin = 132 * 16, nSq = 16 * 16, nFi = 88 * 16, nFo = 16 * 44;
  const int total = 193 + nWin + 3 * nSq + nFi + nFo;
  for (int t = vb; t < total; t += G) {
    if (t < 192) { mod_task(p, t, (float*)smem); continue; }
    if (t == 192) {
      for (int idx = threadIdx.x; idx < 128 * 16; idx += 256) {
        const int pos = idx >> 4, f = idx & 15;
        const float inv = exp2f(-(float)f * (13.287712379549449f / 16.0f));
        const float ang = (float)pos * inv;
        float rev = ang * 0.15915494309189535f; rev -= floorf(rev);
        p.rope[idx * 2 + 0] = __builtin_amdgcn_cosf(rev);
        p.rope[idx * 2 + 1] = __builtin_amdgcn_sinf(rev);
      }
      continue;
    }
    int u = t - 193;
    bf16_t* sm = (bf16_t*)smem;
    if (u < nWin) { wt_tile(p.w_in, 8208, 1024, p.WinT, (u >> 4) * 64, (u & 15) * 64, 1, sm); continue; }
    u -= nWin;
    if (u < nSq) { wt_tile(p.w_a, 1024, 1024, p.WaT, (u >> 4) * 64, (u & 15) * 64, 0, sm); continue; }
    u -= nSq;
    if (u < nSq) { wt_tile(p.w_b, 1024, 1024, p.WbT, (u >> 4) * 64, (u & 15) * 64, 0, sm); continue; }
    u -= nSq;
    if (u < nSq) { wt_tile(p.w_out, 1024, 1024, p.WoT, (u >> 4) * 64, (u & 15) * 64, 0, sm); continue; }
    u -= nSq;
    if (u < nFi) { wt_tile(p.w_ffn_in, 2 * FH, 1024, p.WfiT, (u >> 4) * 64, (u & 15) * 64, 2, sm); continue; }
    u -= nFi;
    wt_tile(p.w_ffn_out, 1024, FH, p.WfoT, (u / 44) * 64, (u % 44) * 64, 0, sm);
  }
}

DI void norm_row2(const float* __restrict__ srcA, const float* __restrict__ srcB, const float* __restrict__ gain, const float* __restrict__ shA, const float* __restrict__ scA,
                  const float* __restrict__ shB, const float* __restrict__ scB, bf16_t* __restrict__ dstA, bf16_t* __restrict__ dstB) {
  const int lane = threadIdx.x & 63;
  f32x4 va[4], vb2[4];
  float sa = 0.f, sb = 0.f;
#pragma unroll
  for (int i = 0; i < 4; ++i) { va[i] = *(const f32x4*)(srcA + (i * 64 + lane) * 4); vb2[i] = *(const f32x4*)(srcB + (i * 64 + lane) * 4); }
#pragma unroll
  for (int i = 0; i < 4; ++i) {
    sa += va[i][0] * va[i][0] + va[i][1] * va[i][1] + va[i][2] * va[i][2] + va[i][3] * va[i][3];
    sb += vb2[i][0] * vb2[i][0] + vb2[i][1] * vb2[i][1] + vb2[i][2] * vb2[i][2] + vb2[i][3] * vb2[i][3];
  }
#pragma unroll
  for (int o = 32; o >= 1; o >>= 1) { sa += __shfl_xor(sa, o); sb += __shfl_xor(sb, o); }
  const float ra = rsqrtf(sa * (1.0f / 1024.0f) + 1e-6f), rb = rsqrtf(sb * (1.0f / 1024.0f) + 1e-6f);
#pragma unroll
  for (int i = 0; i < 4; ++i) {
    const int k = (i * 64 + lane) * 4;
    const f32x4 g = *(const f32x4*)(gain + k);
    const f32x4 a1 = *(const f32x4*)(scA + k), a0 = *(const f32x4*)(shA + k), b1 = *(const f32x4*)(scB + k), b0 = *(const f32x4*)(shB + k);
    float oa[4], ob[4];
#pragma unroll
    for (int r = 0; r < 4; ++r) { oa[r] = va[i][r] * ra * g[r] * (1.f + a1[r]) + a0[r]; ob[r] = vb2[i][r] * rb * g[r] * (1.f + b1[r]) + b0[r]; }
    *(u32x2*)(dstA + k) = (u32x2){pk2(oa[0], oa[1]), pk2(oa[2], oa[3])};
    *(u32x2*)(dstB + k) = (u32x2){pk2(ob[0], ob[1]), pk2(ob[2], ob[3])};
  }
}

template <int NJ, bool SWAP = false>
DI void gemm_kloop(const bf16_t* __restrict__ A, int lda, const bf16_t* __restrict__ Bt, int ldb, int K, f32x16 (&acc)[4][NJ / 2], unsigned char* smem) {
  constexpr int BN = 32 * NJ, NBQ = BN / 32, NSL = 8 + NBQ, QPS = (NSL + 3) / 4, BUF = (256 + BN) * 72;
  int tid = threadIdx.x; asm volatile("" : "+v"(tid));
  const int lane = tid & 63, wid = tid >> 6, wm = wid >> 1, wn = wid & 1;
  const int l32 = lane & 31, hh = lane >> 5;
  const int lr = tid >> 3, lc = (tid & 7) * 8;
  const bf16_t* ap = A + (size_t)lr * lda + lc;
  const bf16_t* bp = Bt + (size_t)lr * ldb + lc;
  bf16_t* s0 = (bf16_t*)smem;
  u32x4 rg[NSL];
  const int nk = K >> 6;
#define SL_LOAD(Q, KT) do { if ((Q) < 8) rg[Q] = *(const u32x4*)(ap + (KT) * 64 + (size_t)(Q) * 32 * lda); \
                            else rg[Q] = *(const u32x4*)(bp + (KT) * 64 + (size_t)((Q) - 8) * 32 * ldb); } while (0)
#define SL_STORE(Q, BASE) do { if ((Q) < 8) *(u32x4*)((BASE) + (lr + 32 * (Q)) * 72 + lc) = rg[Q]; \
                               else *(u32x4*)((BASE) + 256 * 72 + (lr + 32 * ((Q) - 8)) * 72 + lc) = rg[Q]; } while (0)
#pragma unroll
  for (int q = 0; q < NSL; ++q) SL_LOAD(q, 0);
#pragma unroll
  for (int q = 0; q < NSL; ++q) SL_STORE(q, s0);
  {
    const int k1 = nk > 1 ? 1 : 0;
#pragma unroll
    for (int q = 0; q < NSL; ++q) SL_LOAD(q, k1);
  }
  __syncthreads();
#pragma unroll 1
  for (int kt = 0; kt < nk; ++kt) {
    const bf16_t* sa = s0 + (kt & 1) * BUF; const bf16_t* sb = sa + 256 * 72;
    bf16_t* so = s0 + ((kt & 1) ^ 1) * BUF;
    const int k2 = kt + 2 < nk ? kt + 2 : nk - 1;
    bf16x8 af[2][4], bfr[2][NJ / 2];
#pragma unroll
    for (int i = 0; i < 4; ++i) af[0][i] = *(const bf16x8*)(sa + (wm * 128 + i * 32 + l32) * 72 + hh * 8);
#pragma unroll
    for (int j = 0; j < NJ / 2; ++j) bfr[0][j] = *(const bf16x8*)(sb + (wn * 16 * NJ + j * 32 + l32) * 72 + hh * 8);
#pragma unroll
    for (int ks = 0; ks < 4; ++ks) {
      if (ks < 3) {
#pragma unroll
        for (int i = 0; i < 4; ++i) af[(ks + 1) & 1][i] = *(const bf16x8*)(sa + (wm * 128 + i * 32 + l32) * 72 + (ks + 1) * 16 + hh * 8);
#pragma unroll
        for (int j = 0; j < NJ / 2; ++j) bfr[(ks + 1) & 1][j] = *(const bf16x8*)(sb + (wn * 16 * NJ + j * 32 + l32) * 72 + (ks + 1) * 16 + hh * 8);
      }
#pragma unroll
      for (int q = ks * QPS; q < (ks + 1) * QPS && q < NSL; ++q) { SL_STORE(q, so); SL_LOAD(q, k2); }
#pragma unroll
      for (int i = 0; i < 4; ++i)
#pragma unroll
        for (int j = 0; j < NJ / 2; ++j) acc[i][j] = SWAP ? MFMA32(af[ks & 1][i], bfr[ks & 1][j], acc[i][j]) : MFMA32(bfr[ks & 1][j], af[ks & 1][i], acc[i][j]);
#pragma unroll
      for (int g = 0; g < 4 * (NJ / 2); ++g) {
        __builtin_amdgcn_sched_group_barrier(0x008, 1, 0);
        if (ks < 3 && g < 4 + NJ / 2) __builtin_amdgcn_sched_group_barrier(0x100, 1, 0);
        if (g < QPS) { __builtin_amdgcn_sched_group_barrier(0x200, 1, 0); __builtin_amdgcn_sched_group_barrier(0x020, 1, 0); }
      }
      __builtin_amdgcn_sched_barrier(0);
    }
    __syncthreads();
  }
#undef SL_LOAD
#undef SL_STORE
}
template <int NJ2>
DI void acc_zero(f32x16 (&acc)[4][NJ2]) {
#pragma unroll
  for (int i = 0; i < 4; ++i)
#pragma unroll
    for (int j = 0; j < NJ2; ++j) acc[i][j] = zero16();
}
#define EPI_COORDS(NJ) int tid = threadIdx.x; asm volatile("" : "+v"(tid)); const int lane = tid & 63, wid = tid >> 6, wm = wid >> 1, wn = wid & 1, l32 = lane & 31, hh = lane >> 5
DI void tile_map(int t, int NTn, int GM, int& mt, int& nt) { const int per = GM * NTn, g = t / per, r = t % per; mt = g * GM + r % GM; nt = r / GM; }

DI void phase_inproj(const Params& p, int b, int vb, int G, unsigned char* smem) {
  EPI_COORDS(4);
  const int MT = 33, NTn = 66;
  const bf16_t* A = p.xn + (size_t)b * TB * DM;
  for (int t = vb; t < MT * NTn; t += G) {
    int mt, nt; tile_map(t, NTn, 3, mt, nt);
    const int reg = nt >> 3;
    if (nt == 65 || (mt == 32 && (reg == 2 || reg == 3 || reg == 6 || reg == 7))) continue;
    if (nt < 65 && (reg == 1 || reg == 5)) {
      f32x16 acc[4][2]; acc_zero(acc);
      gemm_kloop<4, true>(A + (size_t)mt * 256 * DM, DM, p.WinT + (size_t)nt * 128 * DM, DM, DM, acc, smem);
      bf16_t* dstT = reg == 1 ? p.VTm : p.VTd;
      bf16_t* sT2 = (bf16_t*)smem;
#pragma unroll
      for (int i = 0; i < 4; ++i)
#pragma unroll
        for (int j = 0; j < 2; ++j)
#pragma unroll
          for (int r4 = 0; r4 < 4; ++r4)
            *(u32x2*)(sT2 + (wn * 64 + j * 32 + l32) * 264 + wm * 128 + i * 32 + 8 * r4 + 4 * hh) =
                (u32x2){pk2(acc[i][j][4 * r4], acc[i][j][4 * r4 + 1]), pk2(acc[i][j][4 * r4 + 2], acc[i][j][4 * r4 + 3])};
      __syncthreads();
      {
        const int rrow = tid >> 5, ch = tid & 31;
        bf16_t* dbase = dstT + (size_t)((nt & 7) * 128) * TB + mt * 256 + ch * 8;
#pragma unroll 2
        for (int q = 0; q < 16; ++q) {
          const int row = rrow + 8 * q;
          *(u32x4*)(dbase + (size_t)row * TB) = *(const u32x4*)(sT2 + row * 264 + ch * 8);
        }
      }
      __syncthreads();
      continue;
    }
    f32x16 acc[4][2]; acc_zero(acc);
    gemm_kloop<4>(A + (size_t)mt * 256 * DM, DM, p.WinT + (size_t)nt * 128 * DM, DM, DM, acc, smem);
    if (reg == 3 || reg == 4) {
      const bool isq = reg == 3;
      if (isq && mt == 32) continue;
      const float* gn = isq ? p.q_norm : p.k_norm;
      bf16_t* dst = isq ? p.Qd : p.Kd;
      const int c0 = (nt & 7) * 128 + wn * 64;
      const float osc = isq ? 0.125f * 1.4426950408889634f : 1.0f;
#pragma unroll
      for (int i = 0; i < 4; ++i) {
        const int tau = mt * 256 + wm * 128 + i * 32 + l32;
        float ss = 0.f;
#pragma unroll
        for (int j = 0; j < 2; ++j)
#pragma unroll
          for (int r = 0; r < 16; ++r) ss += acc[i][j][r] * acc[i][j][r];
        ss += __shfl_xor(ss, 32);
        const float rstd = rsqrtf(ss * (1.0f / 64.0f) + 1e-6f);
#pragma unroll
        for (int j = 0; j < 2; ++j) {
          float v[16];
#pragma unroll
          for (int r4 = 0; r4 < 4; ++r4) {
            const f32x4 g4 = *(const f32x4*)(gn + j * 32 + 8 * r4 + 4 * hh);
#pragma unroll
            for (int r = 0; r < 4; ++r) v[4 * r4 + r] = acc[i][j][4 * r4 + r] * rstd * g4[r];
          }
          if (mt < 32) {
            const int pos = j == 0 ? (tau >> 6) : (tau & 63);
            const float* rp = p.rope + pos * 32;
#pragma unroll
            for (int r4 = 0; r4 < 2; ++r4) {
              const f32x4 cs0 = *(const f32x4*)(rp + 2 * (8 * r4 + 4 * hh)), cs1 = *(const f32x4*)(rp + 2 * (8 * r4 + 4 * hh) + 4);
              const float cs[8] = {cs0[0], cs0[1], cs0[2], cs0[3], cs1[0], cs1[1], cs1[2], cs1[3]};
#pragma unroll
              for (int r = 0; r < 4; ++r) {
                const float x1 = v[4 * r4 + r], x2 = v[4 * (r4 + 2) + r], c = cs[2 * r], sn = cs[2 * r + 1];
                v[4 * r4 + r] = x1 * c - x2 * sn; v[4 * (r4 + 2) + r] = x2 * c + x1 * sn;
              }
            }
          }
#pragma unroll
          for (int r4 = 0; r4 < 4; ++r4)
            *(u32x2*)((bf16_t*)smem + (wm * 128 + i * 32 + l32) * 136 + wn * 64 + j * 32 + 8 * r4 + 4 * hh) = (u32x2){pk2(v[4 * r4] * osc, v[4 * r4 + 1] * osc), pk2(v[4 * r4 + 2] * osc, v[4 * r4 + 3] * osc)};
        }
      }
      __syncthreads();
      {
        const int rrow = tid >> 4, ch = tid & 15;
        bf16_t* dbase = dst + (size_t)(mt * 256) * 1024 + (nt & 7) * 128 + ch * 8;
#pragma unroll 2
        for (int q = 0; q < 16; ++q) {
          const int row = rrow + 16 * q;
          *(u32x4*)(dbase + (size_t)row * 1024) = *(const u32x4*)((const bf16_t*)smem + row * 136 + ch * 8);
        }
      }
      __syncthreads();
      continue;
    }
    bf16_t* sT = (bf16_t*)smem;
    if (nt < 64) {
#pragma unroll
      for (int i = 0; i < 4; ++i)
#pragma unroll
        for (int j = 0; j < 2; ++j)
#pragma unroll
          for (int r4 = 0; r4 < 4; ++r4)
            *(u32x2*)(sT + (wm * 128 + i * 32 + l32) * 136 + wn * 64 + j * 32 + 8 * r4 + 4 * hh) =
                (u32x2){pk2(acc[i][j][4 * r4], acc[i][j][4 * r4 + 1]), pk2(acc[i][j][4 * r4 + 2], acc[i][j][4 * r4 + 3])};
      __syncthreads();
      {
        const int rrow = tid >> 4, ch = tid & 15;
        bf16_t* dbase = p.P + (size_t)(mt * 256) * PLD + nt * 128 + ch * 8;
#pragma unroll 2
        for (int q = 0; q < 16; ++q) {
          const int row = rrow + 16 * q;
          *(u32x4*)(dbase + (size_t)row * PLD) = *(const u32x4*)(sT + row * 136 + ch * 8);
        }
      }
      if (reg != 0) { __syncthreads(); continue; }
    }
    if (reg == 0) {
      const int cg = tid & 31, tg = tid >> 5, c0 = nt * 128 + cg * 4, t0 = tg * 32;
      float w[5][4], bias[4];
#pragma unroll
      for (int j = 0; j < 5; ++j) {
        const f32x4 a0 = *(const f32x4*)(p.conv_w + j * 1024 + c0);
#pragma unroll
        for (int e = 0; e < 4; ++e) w[j][e] = a0[e];
      }
      {
        const f32x4 a0 = *(const f32x4*)(p.conv_b + c0);
#pragma unroll
        for (int e = 0; e < 4; ++e) bias[e] = a0[e];
      }
      const float osc = nt < 4 ? 0.08838834764831845f : 1.0f;
      float win[5][4];
#pragma unroll
      for (int j = 0; j < 4; ++j) {
        int rr = t0 - 2 + j; rr = rr < 0 ? 0 : rr;
        const u32x2 v = *(const u32x2*)(sT + rr * 136 + cg * 4);
        win[j + 1][0] = bf_lo(v[0]); win[j + 1][1] = bf_hi(v[0]); win[j + 1][2] = bf_lo(v[1]); win[j + 1][3] = bf_hi(v[1]);
      }
      unsigned outp[4][4];
#pragma unroll
      for (int tt = 0; tt < 32; ++tt) {
#pragma unroll
        for (int j = 0; j < 4; ++j)
#pragma unroll
          for (int e = 0; e < 4; ++e) win[j][e] = win[j + 1][e];
        int rr = t0 + tt + 2; rr = rr > 255 ? 255 : rr;
        const u32x2 v = *(const u32x2*)(sT + rr * 136 + cg * 4);
        win[4][0] = bf_lo(v[0]); win[4][1] = bf_hi(v[0]); win[4][2] = bf_lo(v[1]); win[4][3] = bf_hi(v[1]);
        float o[4];
#pragma unroll
        for (int e = 0; e < 4; ++e) {
          float a = bias[e];
#pragma unroll
          for (int j = 0; j < 5; ++j) a += win[j][e] * w[j][e];
          o[e] = siluf(a) * osc;
        }
        const int tau = mt * 256 + t0 + tt;
        const u32x2 pk = {pk2(o[0], o[1]), pk2(o[2], o[3])};
        if (nt < 4) *(u32x2*)(p.Qm + (size_t)tau * 512 + c0) = pk;
        else {
          *(u32x2*)(p.Km + (size_t)tau * 512 + (c0 - 512)) = pk;
#pragma unroll
          for (int e = 0; e < 4; ++e) {
            const unsigned hv = (e & 1) ? (pk[e >> 1] >> 16) : (pk[e >> 1] & 0xffffu);
            if (tt & 1) outp[e][(tt >> 1) & 3] |= hv << 16; else outp[e][(tt >> 1) & 3] = hv;
          }
          if ((tt & 7) == 7) {
#pragma unroll
            for (int e = 0; e < 4; ++e)
              *(u32x4*)(p.KTm + (size_t)(c0 - 512 + e) * TB + mt * 256 + t0 + (tt & 24)) = (u32x4){outp[e][0], outp[e][1], outp[e][2], outp[e][3]};
          }
        }
      }
      __syncthreads();
    }
    if (nt == 64 && wn == 0) {
#pragma unroll
      for (int i = 0; i < 4; ++i) {
        const int m = mt * 256 + wm * 128 + i * 32 + l32;
#pragma unroll
        for (int r4 = 0; r4 < 2; ++r4) {
          const int gc = 8 * r4 + 4 * hh, type = gc >> 2;
          f32x4 o;
#pragma unroll
          for (int r = 0; r < 4; ++r) {
            float g = acc[i][0][4 * r4 + r] + p.b_gate[gc + r];
            if (type & 1) g = fminf(g, 0.f) - __logf(1.f + __expf(-fabsf(g)));
            o[r] = g;
          }
          *(f32x4*)(p.gates + (size_t)m * 16 + gc) = o;
        }
      }
    }
  }
}

DI void load16(const bf16_t* src, float (&v)[16]) {
  const u32x4 a = *(const u32x4*)src, b2 = *(const u32x4*)(src + 8);
#pragma unroll
  for (int i = 0; i < 4; ++i) { v[2 * i] = bf_lo(a[i]); v[2 * i + 1] = bf_hi(a[i]); v[8 + 2 * i] = bf_lo(b2[i]); v[8 + 2 * i + 1] = bf_hi(b2[i]); }
}
DI void store16(bf16_t* dst, const float (&v)[16]) {
  u32x4 a, b2;
#pragma unroll
  for (int i = 0; i < 4; ++i) { a[i] = pk2(v[2 * i], v[2 * i + 1]); b2[i] = pk2(v[8 + 2 * i], v[8 + 2 * i + 1]); }
  *(u32x4*)dst = a; *(u32x4*)(dst + 8) = b2;
}
DI void tile_transpose_store(bf16_t* sm, const float (&v)[16], bf16_t* dstT, size_t ld, int col0, int tok0) {
  int tid = threadIdx.x; asm volatile("" : "+v"(tid));
  const int r = tid >> 2, seg = tid & 3;
#pragma unroll
  for (int i = 0; i < 16; ++i) sm[r * 66 + seg * 16 + i] = f2bf(v[i]);
  __syncthreads();
  const int col = tid >> 2, ts = (tid & 3) * 16;
  unsigned w[8];
#pragma unroll
  for (int i = 0; i < 8; ++i) w[i] = (unsigned)sm[(ts + 2 * i) * 66 + col] | ((unsigned)sm[(ts + 2 * i + 1) * 66 + col] << 16);
  u32x4* d = (u32x4*)(dstT + (size_t)(col0 + col) * ld + tok0 + ts);
  d[0] = (u32x4){w[0], w[1], w[2], w[3]};
  d[1] = (u32x4){w[4], w[5], w[6], w[7]};
  __syncthreads();
}

DI void scan_step(const Params& p, int chain, int i, float m, bool finalize, float& BL_out, float& pmax_out) {
  int tidl = threadIdx.x; asm volatile("" : "+v"(tidl));
  const int lane = tidl & 63, h = chain >> 1, dir = chain & 1;
  const int gi = (dir ? 8 : 0) + h, gf = (dir ? 12 : 4) + h;
  const int tau0 = i == 0 ? SEQ : (dir ? (32 - i) * 256 : (i - 1) * 256);
  float ig[4], B[4], a[4], pm[4];
  float run = 0.f;
#pragma unroll
  for (int r = 0; r < 4; ++r) {
    const int j = 4 * lane + r, pos = dir ? 255 - j : j;
    const float* g = p.gates + (size_t)(tau0 + pos) * 16;
    ig[r] = g[gi]; run += g[gf]; B[r] = run;
  }
  float inc = run;
#pragma unroll
  for (int o = 1; o < 64; o <<= 1) { const float t = __shfl_up(inc, o); if (lane >= o) inc += t; }
  const float excl = inc - run;
  const float BL = __shfl(inc, 63);
  float rmax = -3.0e38f;
#pragma unroll
  for (int r = 0; r < 4; ++r) { B[r] += excl; a[r] = ig[r] - B[r]; rmax = fmaxf(rmax, a[r]); pm[r] = rmax; }
  float incm = rmax;
#pragma unroll
  for (int o = 1; o < 64; o <<= 1) { const float t = __shfl_up(incm, o); if (lane >= o) incm = fmaxf(incm, t); }
  float exm = __shfl_up(incm, 1); if (lane == 0) exm = -3.0e38f;
  const float pmax_all = __shfl(incm, 63);
  BL_out = BL; pmax_out = pmax_all;
  if (finalize) {
    const float g255 = fmaxf(m, pmax_all);
    float* sc = p.scal + (size_t)(chain * NSTEP + i) * 1024;
#pragma unroll
    for (int r = 0; r < 4; ++r) {
      const int j = 4 * lane + r, pos = dir ? 255 - j : j;
      const float gj = fmaxf(m, fmaxf(exm, pm[r]));
      f32x4 o = {a[r], gj, B[r] + gj, __expf(a[r] - g255)};
      *(f32x4*)(sc + pos * 4) = o;
    }
    if (lane == 0) { p.stepsc[(chain * NSTEP + i) * 2] = m; p.stepsc[(chain * NSTEP + i) * 2 + 1] = __expf(m - g255); }
  }
}
DI void scalar_scan_block(const Params& p, int chain, float* sm) {
  const int lane = threadIdx.x & 63, wid = threadIdx.x >> 6;
  __syncthreads();
  for (int i = wid; i < NSTEP; i += 4) {
    float BL, pm; scan_step(p, chain, i, 0.f, false, BL, pm);
    if (lane == 0) { sm[i] = BL; sm[64 + i] = pm; }
  }
  __syncthreads();
  float m = 0.f;
  for (int i = 0; i < NSTEP; ++i) {
    if ((i & 3) == wid) { float BL, pm; scan_step(p, chain, i, m, true, BL, pm); }
    m = sm[i] + fmaxf(m, sm[64 + i]);
  }
  __syncthreads();
}

DI void phase_prep(const Params& p, int b, int vb, int G, unsigned char* smem) {
  bf16_t* sm = (bf16_t*)smem;
  int tid = threadIdx.x; asm volatile("" : "+v"(tid));
  const int r = tid >> 2, seg = tid & 3;
  const int nA = 33, nB = 0, nC = 0, nD = 0, nE = 0;
  const int total = 8 + nA;
  for (int t = vb; t < total; t += G) {
    if (t < 8) { scalar_scan_block(p, t, (float*)smem); continue; }
    int u = t - 8;
    if (u < nA) {
      const int mtile = u, brow = tid >> 6, c0 = (tid & 63) * 16;
      const int tau = mtile * 256 + (brow < 2 ? brow : 252 + brow);
      const int lo = mtile < 32 ? 0 : SEQ, hi = mtile < 32 ? SEQ : TB;
      float acc[16];
#pragma unroll
      for (int i = 0; i < 16; ++i) acc[i] = p.conv_b[c0 + i];
#pragma unroll
      for (int j = 0; j < 5; ++j) {
        const int t2 = tau + j - 2;
        if (t2 >= lo && t2 < hi) {
          float xv[16]; load16(p.P + (size_t)t2 * PLD + c0, xv);
#pragma unroll
          for (int i = 0; i < 16; ++i) acc[i] += xv[i] * p.conv_w[j * 1024 + c0 + i];
        }
      }
      if (c0 < 512) {
#pragma unroll
        for (int i = 0; i < 16; ++i) acc[i] = siluf(acc[i]) * 0.08838834764831845f;
        store16(p.Qm + (size_t)tau * 512 + c0, acc);
      } else {
#pragma unroll
        for (int i = 0; i < 16; ++i) acc[i] = siluf(acc[i]);
        store16(p.Km + (size_t)tau * 512 + (c0 - 512), acc);
#pragma unroll
        for (int i = 0; i < 16; ++i) p.KTm[(size_t)(c0 - 512 + i) * TB + tau] = f2bf(acc[i]);
      }
      continue;
    }
    u -= nA;
    if (u < nB) {
      const int ct = u & 15, tt = u >> 4, tau = tt * 64 + r;
      float xv[16]; load16(p.P + (size_t)tau * PLD + 1024 + ct * 64 + seg * 16, xv);
      tile_transpose_store(sm, xv, p.VTm, TB, ct * 64, tt * 64);
      continue;
    }
    u -= nB;
    if (u < nC + nD) {
      const bool isq = u < nC;
      if (!isq) u -= nC;
      const int ct = u & 15, tt = u >> 4, tau = tt * 64 + r;
      float xv[16]; load16(p.P + (size_t)tau * PLD + (isq ? 3072 : 4096) + ct * 64 + seg * 16, xv);
      float ss = 0.f;
#pragma unroll
      for (int i = 0; i < 16; ++i) ss += xv[i] * xv[i];
      ss += __shfl_xor(ss, 1); ss += __shfl_xor(ss, 2);
      const float rstd = rsqrtf(ss * (1.0f / 64.0f) + 1e-6f);
      const float* gn = (isq ? p.q_norm : p.k_norm) + seg * 16;
#pragma unroll
      for (int i = 0; i < 16; ++i) xv[i] = xv[i] * rstd * gn[i];
      if (tt < 128) {
        const int pos = seg < 2 ? (tau >> 6) : (tau & 63);
        const float* rp = p.rope + pos * 32;
#pragma unroll
        for (int i = 0; i < 16; ++i) {
          const float other = __shfl_xor(xv[i], 1);
          const float cs = rp[2 * i], sn = rp[2 * i + 1];
          xv[i] = (seg & 1) ? xv[i] * cs + other * sn : xv[i] * cs - other * sn;
        }
      }
      if (isq) {
#pragma unroll
        for (int i = 0; i < 16; ++i) xv[i] *= 0.125f * 1.4426950408889634f;
        store16(p.Qd + (size_t)tau * 1024 + ct * 64 + seg * 16, xv);
      } else {
        store16(p.Kd + (size_t)tau * 1024 + ct * 64 + seg * 16, xv);
      }
      continue;
    }
    u -= nC + nD;
    {
      const int ct = u & 15, tt = u >> 4, tau = tt * 64 + r;
      float xv[16]; load16(p.P + (size_t)tau * PLD + 5120 + ct * 64 + seg * 16, xv);
      tile_transpose_store(sm, xv, p.VTd, TB, ct * 64, tt * 64);
    }
  }
}

DI void phase_mlstm_u(const Params& p, int vb, int G, unsigned char* smem) {
  bf16_t* sV = (bf16_t*)smem;
  bf16_t* sKT = (bf16_t*)(smem + 36864);
  float* sw = (float*)(smem + 36864 + 18432);
  int tid = threadIdx.x; asm volatile("" : "+v"(tid));
  const int lane = tid & 63, wid = tid >> 6, l32 = lane & 31, hh = lane >> 5;
  for (int t = vb; t < 8 * NSTEP; t += G) {
    const int chain = t / NSTEP, i = t % NSTEP, h = chain >> 1, dir = chain & 1;
    const int tau0 = i == 0 ? SEQ : (dir ? (32 - i) * 256 : (i - 1) * 256);
    bf16_t* dstS = p.ST + (size_t)t * (STROWS * 128);
    __syncthreads();
    sw[tid] = p.scal[((size_t)t * 256 + tid) * 4 + 3];
    f32x16 acc[4][2];
#pragma unroll
    for (int a = 0; a < 4; ++a) { acc[a][0] = zero16(); acc[a][1] = zero16(); }
    float nsum = 0.f;
    for (int st = 0; st < 4; ++st) {
      __syncthreads();
      {
        const int seg = tid & 7;
#pragma unroll
        for (int q = 0; q < 8; ++q) {
          const int e = (tid >> 3) + 32 * q;
          *(u32x4*)(sV + e * 72 + seg * 8) = *(const u32x4*)(p.VTm + (size_t)(h * 256 + e) * TB + tau0 + st * 64 + seg * 8);
        }
#pragma unroll
        for (int q = 0; q < 4; ++q) {
          const int d = (tid >> 3) + 32 * q;
          const u32x4 kv = *(const u32x4*)(p.KTm + (size_t)(h * 128 + d) * TB + tau0 + st * 64 + seg * 8);
          const float* wp = sw + st * 64 + seg * 8;
          u32x4 o;
#pragma unroll
          for (int z = 0; z < 4; ++z) o[z] = pk2(bf_lo(kv[z]) * wp[2 * z], bf_hi(kv[z]) * wp[2 * z + 1]);
          *(u32x4*)(sKT + d * 72 + seg * 8) = o;
        }
      }
      __syncthreads();
#pragma unroll
      for (int ks = 0; ks < 4; ++ks) {
        bf16x8 kf[4], vf[2];
#pragma unroll
        for (int a = 0; a < 4; ++a) kf[a] = *(const bf16x8*)(sKT + (a * 32 + l32) * 72 + ks * 16 + hh * 8);
#pragma unroll
        for (int e2 = 0; e2 < 2; ++e2) vf[e2] = *(const bf16x8*)(sV + ((wid + 4 * e2) * 32 + l32) * 72 + ks * 16 + hh * 8);
#pragma unroll
        for (int a = 0; a < 4; ++a)
#pragma unroll
          for (int e2 = 0; e2 < 2; ++e2) acc[a][e2] = MFMA32(kf[a], vf[e2], acc[a][e2]);
      }
      if (tid < 128) {
#pragma unroll 8
        for (int s = 0; s < 64; ++s) nsum += bf2f(sKT[tid * 72 + s]);
      }
    }
#pragma unroll
    for (int a = 0; a < 4; ++a)
#pragma unroll
      for (int e2 = 0; e2 < 2; ++e2) {
        const int e = (wid + 4 * e2) * 32 + l32;
#pragma unroll
        for (int i4 = 0; i4 < 4; ++i4) {
          const int d0 = a * 32 + 8 * i4 + 4 * hh;
          const f32x16& v = acc[a][e2];
          *(u32x2*)(dstS + (size_t)e * 128 + d0) = (u32x2){pk2(v[4 * i4], v[4 * i4 + 1]), pk2(v[4 * i4 + 2], v[4 * i4 + 3])};
        }
      }
    if (tid < 128) dstS[256 * 128 + tid] = f2bf(nsum);
    for (int idx = tid; idx < 31 * 128 / 2; idx += 256) ((unsigned*)(dstS + 257 * 128))[idx] = 0u;
  }
}

DI void phase_mlstm_scan(const Params& p, int vb, int G) {
  const int pairs = STROWS * 128 / 2;
  const int ntask = 8 * pairs / 256;
  for (int t = vb; t < ntask; t += G) {
    int tidl = threadIdx.x; asm volatile("" : "+v"(tidl));
    const int gidx = t * 256 + tidl;
    const int chain = gidx / pairs, e2 = gidx % pairs;
    unsigned* base = (unsigned*)(p.ST + (size_t)chain * NSTEP * (STROWS * 128)) + e2;
    unsigned u[NSTEP];
#pragma unroll
    for (int i = 0; i < NSTEP; ++i) u[i] = base[(size_t)i * pairs];
    float s0 = 0.f, s1 = 0.f;
#pragma unroll
    for (int i = 0; i < NSTEP; ++i) {
      const float dec = p.stepsc[(chain * NSTEP + i) * 2 + 1];
      base[(size_t)i * pairs] = pk2(s0, s1);
      s0 = dec * s0 + bf_lo(u[i]); s1 = dec * s1 + bf_hi(u[i]);
    }
  }
}

DI void mlstm_out_task(const Params& p, int task, unsigned char* smem) {
  const int half = task & 1, c = (task >> 1) & 31, h = task >> 6;
  bf16_t* sK = (bf16_t*)smem;
  bf16_t* sV = (bf16_t*)(smem + 17408);
  float* sA = (float*)(smem + 17408 + 36864);
  bf16_t* sC = (bf16_t*)(smem + 17408 + 36864 + 1024);
  int tid = threadIdx.x; asm volatile("" : "+v"(tid));
  const int lane = tid & 63, wid = tid >> 6, l32 = lane & 31, hh = lane >> 5;
  const int qi = half * 4 + wid, pq = qi * 32 + l32, tq = c * 256 + pq;
  bf16x8 qf[8];
#pragma unroll
  for (int ks = 0; ks < 8; ++ks) qf[ks] = *(const bf16x8*)(p.Qm + (size_t)tq * 512 + h * 128 + ks * 16 + hh * 8);
  bf16_t* hrow = p.hA + (size_t)tq * 1024 + h * 256;
  f32x16 num[8];
#pragma unroll 1
  for (int dir = 0; dir < 2; ++dir) {
    const int chain = h * 2 + dir, i = dir ? 32 - c : c + 1, sbase = chain * NSTEP + i;
    const float* sc = p.scal + (size_t)sbase * 1024;
    const float m_prev = p.stepsc[sbase * 2];
    const float g_q = sc[pq * 4 + 1], mj_q = sc[pq * 4 + 2];
    __syncthreads();
    sA[tid] = sc[tid * 4];
    {
      const bf16_t* Csrc = p.ST + (size_t)sbase * (STROWS * 128) + (size_t)(tid >> 4) * 128 + (tid & 15) * 8;
      bf16_t* sCd = sC + (tid >> 4) * 136 + (tid & 15) * 8;
#pragma unroll 6
      for (int q = 0; q < 18; ++q) *(u32x4*)(sCd + q * 16 * 136) = *(const u32x4*)(Csrc + (size_t)q * 16 * 128);
    }
    f32x16 dent = zero16();
#pragma unroll
    for (int eb = 0; eb < 8; ++eb) num[eb] = zero16();
    float rs = 0.f;
    const int st_lo = dir == 0 ? 0 : half * 2, st_hi = dir == 0 ? half * 2 + 1 : 3;
    u32x4 rk[4], rv[8];
    {
      const int seg = tid & 15, sg = tid & 7;
#pragma unroll
      for (int q = 0; q < 4; ++q) rk[q] = *(const u32x4*)(p.Km + (size_t)(c * 256 + st_lo * 64 + (tid >> 4) + 16 * q) * 512 + h * 128 + seg * 8);
#pragma unroll
      for (int q = 0; q < 8; ++q) rv[q] = *(const u32x4*)(p.VTm + (size_t)(h * 256 + (tid >> 3) + 32 * q) * TB + c * 256 + st_lo * 64 + sg * 8);
    }
#pragma unroll 1
    for (int st = st_lo; st <= st_hi; ++st) {
      __syncthreads();
      {
        const int seg = tid & 15, sg = tid & 7;
#pragma unroll
        for (int q = 0; q < 4; ++q) *(u32x4*)(sK + ((tid >> 4) + 16 * q) * 136 + seg * 8) = rk[q];
#pragma unroll
        for (int q = 0; q < 8; ++q) *(u32x4*)(sV + ((tid >> 3) + 32 * q) * 72 + sg * 8) = rv[q];
      }
      __syncthreads();
      {
        const int sn = st < st_hi ? st + 1 : st;
        const int seg = tid & 15, sg = tid & 7;
#pragma unroll
        for (int q = 0; q < 4; ++q) rk[q] = *(const u32x4*)(p.Km + (size_t)(c * 256 + sn * 64 + (tid >> 4) + 16 * q) * 512 + h * 128 + seg * 8);
#pragma unroll
        for (int q = 0; q < 8; ++q) rv[q] = *(const u32x4*)(p.VTm + (size_t)(h * 256 + (tid >> 3) + 32 * q) * TB + c * 256 + sn * 64 + sg * 8);
      }
#pragma unroll 1
      for (int sub = 0; sub < 2; ++sub) {
        const int ki = st * 2 + sub;
        const bool need = dir == 0 ? ki <= qi : ki >= qi;
        if (!need) continue;
        f32x16 S = zero16();
#pragma unroll
        for (int ks = 0; ks < 8; ++ks) {
          const bf16x8 a = *(const bf16x8*)(sK + (sub * 32 + l32) * 136 + ks * 16 + hh * 8);
          S = MFMA32(a, qf[ks], S);
        }
#pragma unroll
        for (int i4 = 0; i4 < 4; ++i4) {
          const f32x4 av = *(const f32x4*)(sA + ki * 32 + 8 * i4 + 4 * hh);
#pragma unroll
          for (int r = 0; r < 4; ++r) {
            const int sp = ki * 32 + 8 * i4 + 4 * hh + r;
            const bool ok = dir == 0 ? sp <= pq : sp >= pq;
            const float dm = ok ? __expf(av[r] - g_q) : 0.f;
            const float v = S[4 * i4 + r] * dm;
            S[4 * i4 + r] = v; rs += v;
          }
        }
        const bf16x8 pf0 = pack8(S, 0), pf1 = pack8(S, 1);
#pragma unroll
        for (int eb = 0; eb < 8; ++eb) {
          const bf16_t* vr = sV + (eb * 32 + l32) * 72 + sub * 32 + 4 * hh;
          const bf16x8 v0 = cat4(*(const u32x2*)(vr), *(const u32x2*)(vr + 8));
          const bf16x8 v1 = cat4(*(const u32x2*)(vr + 16), *(const u32x2*)(vr + 24));
          num[eb] = MFMA32(v0, pf0, num[eb]);
          num[eb] = MFMA32(v1, pf1, num[eb]);
        }
      }
    }
    const float inter = __expf(m_prev - g_q);
    const bf16_t* Cst = p.ST + (size_t)sbase * (STROWS * 128);
    {
      bf16x8 cf[2][8];
#pragma unroll
      for (int ks = 0; ks < 8; ++ks) cf[0][ks] = *(const bf16x8*)(sC + l32 * 136 + ks * 16 + hh * 8);
#pragma unroll
      for (int eb = 0; eb < 9; ++eb) {
        if (eb < 8) {
#pragma unroll
          for (int ks = 0; ks < 8; ++ks) cf[(eb + 1) & 1][ks] = *(const bf16x8*)(sC + ((eb + 1) * 32 + l32) * 136 + ks * 16 + hh * 8);
        }
        f32x16 tmp = zero16();
#pragma unroll
        for (int ks = 0; ks < 8; ++ks) tmp = MFMA32(cf[eb & 1][ks], qf[ks], tmp);
        if (eb < 8) {
#pragma unroll
          for (int r = 0; r < 16; ++r) num[eb][r] += inter * tmp[r];
        } else {
          dent = tmp;
        }
        __builtin_amdgcn_sched_barrier(0);
      }
    }
    rs += __shfl_xor(rs, 32);
    const float dn = inter * __shfl(dent[0], l32);
    const float den = rs + dn;
    const float inv = 1.0f / fmaxf(fabsf(den), __expf(-mj_q));
    if (dir == 0) {
#pragma unroll
      for (int eb = 0; eb < 8; ++eb)
#pragma unroll
        for (int i4 = 0; i4 < 4; ++i4) {
          const f32x16& v = num[eb];
          *(u32x2*)(hrow + eb * 32 + 8 * i4 + 4 * hh) = (u32x2){pk2(v[4 * i4] * inv, v[4 * i4 + 1] * inv), pk2(v[4 * i4 + 2] * inv, v[4 * i4 + 3] * inv)};
        }
    } else {
#pragma unroll
      for (int eb = 0; eb < 8; ++eb)
#pragma unroll
        for (int i4 = 0; i4 < 4; ++i4) {
          const u32x2 st2 = *(const u32x2*)(hrow + eb * 32 + 8 * i4 + 4 * hh);
          num[eb][4 * i4 + 0] = bf_lo(st2[0]) + num[eb][4 * i4 + 0] * inv;
          num[eb][4 * i4 + 1] = bf_hi(st2[0]) + num[eb][4 * i4 + 1] * inv;
          num[eb][4 * i4 + 2] = bf_lo(st2[1]) + num[eb][4 * i4 + 2] * inv;
          num[eb][4 * i4 + 3] = bf_hi(st2[1]) + num[eb][4 * i4 + 3] * inv;
          if (i4 == 3) asm volatile("" ::: "memory");
        }
    }
  }
  float ss = 0.f;
#pragma unroll
  for (int eb = 0; eb < 8; ++eb)
#pragma unroll
    for (int r = 0; r < 16; ++r) ss += num[eb][r] * num[eb][r];
  ss += __shfl_xor(ss, 32);
  const float rstd = rsqrtf(ss * (1.0f / 256.0f) + 1e-6f);
  const bf16_t* morow = p.P + (size_t)tq * PLD + 2048 + h * 256;
#pragma unroll
  for (int eb = 0; eb < 8; ++eb)
#pragma unroll
    for (int i4 = 0; i4 < 4; ++i4) {
      const int e0 = eb * 32 + 8 * i4 + 4 * hh;
      const f32x4 gn = *(const f32x4*)(p.mlstm_norm + h * 256 + e0);
      const u32x2 mo = *(const u32x2*)(morow + e0);
      const float o0 = num[eb][4 * i4 + 0] * rstd * gn[0] * sigmf(bf_lo(mo[0]));
      const float o1 = num[eb][4 * i4 + 1] * rstd * gn[1] * sigmf(bf_hi(mo[0]));
      const float o2 = num[eb][4 * i4 + 2] * rstd * gn[2] * sigmf(bf_lo(mo[1]));
      const float o3 = num[eb][4 * i4 + 3] * rstd * gn[3] * sigmf(bf_hi(mo[1]));
      *(u32x2*)(hrow + e0) = (u32x2){pk2(o0, o1), pk2(o2, o3)};
      if ((i4 & 1) == 1) asm volatile("" ::: "memory");
    }
}

DI void attn_task(const Params& p, int task, unsigned char* smem) {
  const int h = task >> 6, qb = task & 63;
  bf16_t* sK = (bf16_t*)smem;
  int tid = threadIdx.x; asm volatile("" : "+v"(tid));
  const int lane = tid & 63, wid = tid >> 6, l32 = lane & 31, hh = lane >> 5;
  const int tq = qb * 128 + wid * 32 + l32;
  float lam, M2;
  {
    const float* lv = p.lam_vecs;
    float a = lv[lane] * lv[64 + lane], b2 = lv[128 + lane] * lv[192 + lane];
    float gq = fabsf(p.q_norm[lane]), gk = fabsf(p.k_norm[lane]);
#pragma unroll
    for (int o = 32; o >= 1; o >>= 1) { a += __shfl_xor(a, o); b2 += __shfl_xor(b2, o); gq = fmaxf(gq, __shfl_xor(gq, o)); gk = fmaxf(gk, __shfl_xor(gk, o)); }
    lam = __expf(a) - __expf(b2) + 0.2f;
    M2 = 8.0f * 1.4426950408889634f * gq * gk;
  }
  bf16x8 qf[2][4];
#pragma unroll
  for (int mp = 0; mp < 2; ++mp)
#pragma unroll
    for (int s = 0; s < 4; ++s) qf[mp][s] = *(const bf16x8*)(p.Qd + (size_t)tq * 1024 + h * 128 + mp * 64 + s * 16 + hh * 8);
  f32x16 O[2][4];
#pragma unroll
  for (int mp = 0; mp < 2; ++mp)
#pragma unroll
    for (int eb = 0; eb < 4; ++eb) O[mp][eb] = zero16();
  float ls0 = 0.f, ls1 = 0.f;
  f32x16 minit;
#pragma unroll
  for (int r = 0; r < 16; ++r) minit[r] = -M2;
  const int kr = tid >> 4, kseg = tid & 15, vr = tid >> 3, vseg = tid & 7;
  const bf16_t* kg = p.Kd + (size_t)kr * 1024 + h * 128 + kseg * 8;
  const bf16_t* vg = p.VTd + (size_t)(h * 128 + vr) * TB + vseg * 8;
  constexpr int ABUF = 64 * 136 + 128 * 72;
  u32x4 rg[8];
#define A_LOAD(Q, KT) do { if ((Q) < 4) rg[Q] = *(const u32x4*)(kg + (size_t)((KT) * 64 + 16 * (Q)) * 1024); \
                           else rg[Q] = *(const u32x4*)(vg + (size_t)(32 * ((Q) - 4)) * TB + (KT) * 64); } while (0)
#define A_STORE(Q, BASE) do { if ((Q) < 4) *(u32x4*)((BASE) + (kr + 16 * (Q)) * 136 + kseg * 8) = rg[Q]; \
                              else *(u32x4*)((BASE) + 64 * 136 + (vr + 32 * ((Q) - 4)) * 72 + vseg * 8) = rg[Q]; } while (0)
  const int NKT = TB / 64;
  __syncthreads();
#pragma unroll
  for (int q = 0; q < 8; ++q) A_LOAD(q, 0);
#pragma unroll
  for (int q = 0; q < 8; ++q) A_STORE(q, sK);
#pragma unroll
  for (int q = 0; q < 8; ++q) A_LOAD(q, 1);
  __syncthreads();
#pragma unroll 1
  for (int kt = 0; kt < NKT; ++kt) {
    const bf16_t* cK = sK + (kt & 1) * ABUF; const bf16_t* cV = cK + 64 * 136;
    bf16_t* so = sK + ((kt & 1) ^ 1) * ABUF;
    const int k2 = kt + 2 < NKT ? kt + 2 : NKT - 1;
#pragma unroll
    for (int sub = 0; sub < 2; ++sub) {
      bf16x8 pf[2][2];
#pragma unroll
      for (int mp = 0; mp < 2; ++mp) {
        f32x16 S = minit;
#pragma unroll
        for (int s = 0; s < 4; ++s) {
          const bf16x8 a = *(const bf16x8*)(cK + (sub * 32 + l32) * 136 + mp * 64 + s * 16 + hh * 8);
          S = MFMA32(a, qf[mp][s], S);
        }
        float l = 0.f;
#pragma unroll
        for (int r = 0; r < 16; ++r) { S[r] = __builtin_amdgcn_exp2f(S[r]); l += S[r]; }
        if (mp == 0) ls0 += l; else ls1 += l;
        pf[mp][0] = pack8(S, 0); pf[mp][1] = pack8(S, 1);
      }
#pragma unroll
      for (int q = sub * 4; q < sub * 4 + 4; ++q) { A_STORE(q, so); A_LOAD(q, k2); }
#pragma unroll
      for (int eb = 0; eb < 4; ++eb) {
        const bf16_t* vrp = cV + (eb * 32 + l32) * 72 + sub * 32 + 4 * hh;
        const bf16x8 v0 = cat4(*(const u32x2*)(vrp), *(const u32x2*)(vrp + 8));
        const bf16x8 v1 = cat4(*(const u32x2*)(vrp + 16), *(const u32x2*)(vrp + 24));
        O[0][eb] = MFMA32(v0, pf[0][0], O[0][eb]);
        O[1][eb] = MFMA32(v0, pf[1][0], O[1][eb]);
        O[0][eb] = MFMA32(v1, pf[0][1], O[0][eb]);
        O[1][eb] = MFMA32(v1, pf[1][1], O[1][eb]);
      }
    }
    __syncthreads();
  }
#undef A_LOAD
#undef A_STORE
  ls0 += __shfl_xor(ls0, 32); ls1 += __shfl_xor(ls1, 32);
  const float i0 = 1.0f / ls0, i1 = lam / ls1;
  float ss = 0.f;
#pragma unroll
  for (int eb = 0; eb < 4; ++eb)
#pragma unroll
    for (int r = 0; r < 16; ++r) { const float o = O[0][eb][r] * i0 - O[1][eb][r] * i1; O[0][eb][r] = o; ss += o * o; }
  ss += __shfl_xor(ss, 32);
  const float rstd = rsqrtf(ss * (1.0f / 128.0f) + 1e-6f) * 0.8f;
  bf16_t* orow = p.hB + (size_t)tq * 1024 + h * 128;
#pragma unroll
  for (int eb = 0; eb < 4; ++eb)
#pragma unroll
    for (int i4 = 0; i4 < 4; ++i4) {
      const int e0 = eb * 32 + 8 * i4 + 4 * hh;
      const f32x4 gn = *(const f32x4*)(p.diff_norm + e0);
      const f32x16& o = O[0][eb];
      *(u32x2*)(orow + e0) = (u32x2){pk2(o[4 * i4] * rstd * gn[0], o[4 * i4 + 1] * rstd * gn[1]), pk2(o[4 * i4 + 2] * rstd * gn[2], o[4 * i4 + 3] * rstd * gn[3])};
    }
}

DI void phase_merge(const Params& p, int vb, int G, unsigned char* smem) {
  EPI_COORDS(4);
  for (int t = vb; t < 32 * 8; t += G) {
    int mt, nt; tile_map(t, 8, 4, mt, nt);
    f32x16 acc[4][2];
    acc_zero(acc);
    gemm_kloop<4>(p.hA + (size_t)mt * 256 * DM, DM, p.WaT + (size_t)nt * 128 * DM, DM, DM, acc, smem);
#pragma unroll
    for (int i = 0; i < 4; ++i) {
      const int m = mt * 256 + wm * 128 + i * 32 + l32;
#pragma unroll
      for (int j = 0; j < 2; ++j)
#pragma unroll
        for (int r4 = 0; r4 < 4; ++r4) {
          const int n = nt * 128 + wn * 64 + j * 32 + 8 * r4 + 4 * hh;
          const u32x2 g = *(const u32x2*)(p.P + (size_t)m * PLD + 6144 + n);
          *(u32x2*)(p.y + (size_t)m * DM + n) = (u32x2){pk2(sigmf(bf_lo(g[0])) * acc[i][j][4 * r4 + 0], sigmf(bf_hi(g[0])) * acc[i][j][4 * r4 + 1]),
                                                        pk2(sigmf(bf_lo(g[1])) * acc[i][j][4 * r4 + 2], sigmf(bf_hi(g[1])) * acc[i][j][4 * r4 + 3])};
        }
    }
    acc_zero(acc);
    gemm_kloop<4>(p.hB + (size_t)mt * 256 * DM, DM, p.WbT + (size_t)nt * 128 * DM, DM, DM, acc, smem);
#pragma unroll
    for (int i = 0; i < 4; ++i) {
      const int m = mt * 256 + wm * 128 + i * 32 + l32;
#pragma unroll
      for (int j = 0; j < 2; ++j)
#pragma unroll
        for (int r4 = 0; r4 < 4; ++r4) {
          const int n = nt * 128 + wn * 64 + j * 32 + 8 * r4 + 4 * hh;
          const u32x2 g = *(const u32x2*)(p.P + (size_t)m * PLD + 7168 + n);
          const u32x2 y0 = *(const u32x2*)(p.y + (size_t)m * DM + n);
          const float o0 = bf_lo(y0[0]) + sigmf(bf_lo(g[0])) * acc[i][j][4 * r4 + 0], o1 = bf_hi(y0[0]) + sigmf(bf_hi(g[0])) * acc[i][j][4 * r4 + 1];
          const float o2 = bf_lo(y0[1]) + sigmf(bf_lo(g[1])) * acc[i][j][4 * r4 + 2], o3 = bf_hi(y0[1]) + sigmf(bf_hi(g[1])) * acc[i][j][4 * r4 + 3];
          *(u32x2*)(p.y + (size_t)m * DM + n) = (u32x2){pk2(o0, o1), pk2(o2, o3)};
        }
    }
  }
}

DI void phase_outproj(const Params& p, int b, int vb, int G, unsigned char* smem) {
  EPI_COORDS(4);
  for (int t = vb; t < 32 * 8; t += G) {
    int mt, nt; tile_map(t, 8, 4, mt, nt);
    f32x16 acc[4][2]; acc_zero(acc);
    gemm_kloop<4>(p.y + (size_t)mt * 256 * DM, DM, p.WoT + (size_t)nt * 128 * DM, DM, DM, acc, smem);
#pragma unroll
    for (int i = 0; i < 4; ++i) {
      const int m = mt * 256 + wm * 128 + i * 32 + l32;
      const size_t row = (size_t)(b * SEQ + m) * DM;
#pragma unroll
      for (int j = 0; j < 2; ++j)
#pragma unroll
        for (int r4 = 0; r4 < 4; ++r4) {
          const int n = nt * 128 + wn * 64 + j * 32 + 8 * r4 + 4 * hh;
          const f32x4 xv = *(const f32x4*)(p.x + row + n), g1 = *(const f32x4*)(p.mod + b * 6144 + 2048 + n);
          f32x4 o;
#pragma unroll
          for (int r = 0; r < 4; ++r) o[r] = xv[r] + g1[r] * acc[i][j][4 * r4 + r];
          *(f32x4*)(p.out + row + n) = o;
        }
    }
  }
}

template <int PROBE>
DI void phase_ffn_in(const Params& p, int vb, int G, unsigned char* smem) {
  EPI_COORDS(4);
  for (int t = vb; t < 128 * 44; t += G) {
    int mt, nt; tile_map(t, 44, 4, mt, nt);
    f32x16 acc[4][2]; acc_zero(acc);
    gemm_kloop<4>(p.xn2 + (size_t)(PROBE == 1 ? 0 : mt) * 256 * DM, DM, p.WfiT + (size_t)(PROBE == 1 ? 0 : nt) * 128 * DM, DM, DM, acc, smem);
#pragma unroll
    for (int i = 0; i < 4; ++i) {
      const int m = mt * 256 + wm * 128 + i * 32 + l32;
#pragma unroll
      for (int r4 = 0; r4 < 4; ++r4) {
        const int hc = (nt * 2 + wn) * 32 + 8 * r4 + 4 * hh;
        float o[4];
#pragma unroll
        for (int r = 0; r < 4; ++r) o[r] = siluf(acc[i][0][4 * r4 + r]) * acc[i][1][4 * r4 + r];
        bf16_t* hdst = PROBE ? p.hid + (size_t)NB * SEQ * FH + (size_t)(m & 8191) * FH : p.hid + (size_t)m * FH;
        *(u32x2*)(hdst + hc) = (u32x2){pk2(o[0], o[1]), pk2(o[2], o[3])};
      }
    }
  }
}

DI void phase_ffn_out(const Params& p, int vb, int G, unsigned char* smem) {
  EPI_COORDS(8);
  for (int t = vb; t < 128 * 4; t += G) {
    int mt, nt; tile_map(t, 4, 8, mt, nt);
    f32x16 acc[4][4]; acc_zero(acc);
    gemm_kloop<8>(p.hid + (size_t)mt * 256 * FH, FH, p.WfoT + (size_t)nt * 256 * FH, FH, FH, acc, smem);
#pragma unroll
    for (int i = 0; i < 4; ++i) {
      const int m = mt * 256 + wm * 128 + i * 32 + l32;
      const int b = m >> 13;
#pragma unroll
      for (int j = 0; j < 4; ++j)
#pragma unroll
        for (int r4 = 0; r4 < 4; ++r4) {
          const int n = nt * 256 + wn * 128 + j * 32 + 8 * r4 + 4 * hh;
          float* op = p.out + (size_t)m * DM + n;
          const f32x4 xv = *(const f32x4*)op, g2 = *(const f32x4*)(p.mod + b * 6144 + 5120 + n);
          f32x4 o;
#pragma unroll
          for (int r = 0; r < 4; ++r) o[r] = xv[r] + g2[r] * acc[i][j][4 * r4 + r];
          *(f32x4*)op = o;
        }
    }
  }
}

#define XB_TMO      128
#define XB_XCNT(j)  (256  + 64 * (j))
#define XB_XSUB(j)  (1280 + 64 * (j))
#define XB_XGEN(j)  (2304 + 64 * (j))
#define XB_TOP      3328
#define XB_TOPGEN   3392
#define XCD_BAR_WORDS 3456
#define XB_SPIN_CAP (1u << 22)
#define LAS __attribute__((address_space(3)))
DI unsigned xb_ld(unsigned* p) { return __hip_atomic_load(p, __ATOMIC_RELAXED, __HIP_MEMORY_SCOPE_AGENT); }
DI unsigned xb_add(unsigned* p, unsigned v) { return __hip_atomic_fetch_add(p, v, __ATOMIC_RELAXED, __HIP_MEMORY_SCOPE_AGENT); }
DI unsigned xb_xcc_id() { return (unsigned)__builtin_amdgcn_s_getreg((3 << 11) | 20) & 0xFu; }
#define XB_SPIN(cond, bar) do { unsigned _sp = 0; while (cond) { __builtin_amdgcn_s_sleep(1); \
    if ((++_sp & 255u) == 0u) { if (xb_ld(&(bar)[XB_TMO])) break; if (_sp > XB_SPIN_CAP) { atomicAdd(&(bar)[XB_TMO], 1u); break; } } } } while (0)
struct XcdBarrier { unsigned* bar; unsigned x; volatile LAS unsigned* st; };
DI XcdBarrier xcd_barrier_post(unsigned* bar, volatile LAS unsigned* st) {
  XcdBarrier b; b.bar = bar; b.x = xb_xcc_id(); b.st = st;
  if (threadIdx.x == 0) st[2] = xb_add(&bar[XB_XCNT(b.x)], 1u);
  return b;
}
DI void xcd_barrier_complete(unsigned* bar, unsigned x, unsigned& nloc, unsigned& nx) {
  const unsigned G = gridDim.x * gridDim.y * gridDim.z;
  unsigned sum, cnt, mine, sp = 0u;
  for (;;) {
    sum = 0u; cnt = 0u; mine = 0u;
#pragma unroll
    for (unsigned j = 0; j < 16; ++j) { const unsigned c = xb_ld(&bar[XB_XCNT(j)]); sum += c; cnt += (c > 0u) ? 1u : 0u; mine = (j == x) ? c : mine; }
    if (sum == G) break;
    __builtin_amdgcn_s_sleep(1);
    if ((++sp & 255u) == 0u) { if (xb_ld(&bar[XB_TMO])) break; if (sp > XB_SPIN_CAP) { atomicAdd(&bar[XB_TMO], 1u); break; } }
  }
  nloc = mine > 0u ? mine : 1u; nx = cnt > 0u ? cnt : 1u;
}
DI void xcd_barrier(const XcdBarrier& b) {
  asm volatile("s_waitcnt vmcnt(0)" ::: "memory");
  __syncthreads();
  if (threadIdx.x == 0) {
    unsigned* bar = b.bar;
    __builtin_amdgcn_s_waitcnt(0);
    unsigned nloc = b.st[0], nx = b.st[1];
    if (nloc == 0u) { xcd_barrier_complete(bar, b.x, nloc, nx); b.st[0] = nloc; b.st[1] = nx; }
    const unsigned old = xb_add(&bar[XB_XSUB(b.x)], 1u);
    const unsigned gen = old / nloc;
    if (old + 1u == (gen + 1u) * nloc) {
      __builtin_amdgcn_fence(__ATOMIC_RELEASE, "agent");
      asm volatile("s_waitcnt vmcnt(0)" ::: "memory");
      const unsigned og = xb_add(&bar[XB_TOP], 1u);
      const unsigned tg = og / nx;
      if (og + 1u == (tg + 1u) * nx) xb_add(&bar[XB_TOPGEN], 1u);
      else XB_SPIN(xb_ld(&bar[XB_TOPGEN]) == tg, bar);
      __builtin_amdgcn_fence(__ATOMIC_ACQUIRE, "agent");
      xb_add(&bar[XB_XGEN(b.x)], 1u);
      asm volatile("s_waitcnt vmcnt(0)" ::: "memory");
    } else {
      XB_SPIN(xb_ld(&bar[XB_XGEN(b.x)]) == gen, bar);
      __builtin_amdgcn_fence(__ATOMIC_ACQUIRE, "agent");
      asm volatile("s_waitcnt vmcnt(0)" ::: "memory");
    }
  }
  __syncthreads();
}

#ifndef PHMASK
#define PHMASK 0xFFFF
#endif
#define PH(n) ((PHMASK >> (n)) & 1)
#ifndef REPMASK
#define REPMASK 0
#endif
#define NREP(n) (1 + ((REPMASK >> (n)) & 1))
#define GSYNC() do { xcd_barrier(xb); if ((REPMASK >> 15) & 1) xcd_barrier(xb); } while (0)
__global__ void __launch_bounds__(256, 1) hybrid_block_megakernel(Params p) {
  cg::grid_group grid = cg::this_grid();
  __shared__ __attribute__((aligned(16))) unsigned char smem[SMEM_BYTES];
  const int G = gridDim.x, bid = blockIdx.x;
  int vb = bid;
  const int wid = threadIdx.x >> 6;
  __shared__ __attribute__((aligned(16))) unsigned xb_words[4];
  if (threadIdx.x < 4) xb_words[threadIdx.x] = 0u;
  __syncthreads();
  const XcdBarrier xb = xcd_barrier_post(p.bar, (volatile LAS unsigned*)xb_words);

  if (PH(0)) phase0(p, vb, G, smem);
  grid.sync();
  GSYNC();
  if (threadIdx.x == 0) {
    bool even = (G % 8) == 0 && xb.x < 8u;
    for (unsigned j = 0; j < 16; ++j) { const unsigned cnt = xb_ld(&p.bar[XB_XCNT(j)]); if (cnt != (j < 8u ? (unsigned)(G / 8) : 0u)) even = false; }
    xb_words[3] = even ? 1u : 0u;
  }
  __syncthreads();
  if (xb_words[3]) vb = (int)xb.x * (G / 8) + (int)xb_words[2];
  for (int t = vb; t < NB * TB / 8; t += G) {
    const int R0 = t * 8 + wid * 2;
    const float* src[2]; const float* md[2];
#pragma unroll
    for (int z = 0; z < 2; ++z) {
      const int R = R0 + z, b = R / TB, tau = R % TB;
      src[z] = tau < SEQ ? p.x + (size_t)(b * SEQ + tau) * DM : p.ctx + (size_t)(b * CTXL + tau - SEQ) * DM;
      md[z] = p.mod + (tau < SEQ ? b : 4) * 6144;
    }
    norm_row2(src[0], src[1], p.norm1, md[0], md[0] + 1024, md[1], md[1] + 1024, p.xn + (size_t)R0 * DM, p.xn + (size_t)(R0 + 1) * DM);
  }
  GSYNC();
  for (int b = 0; b < NB; ++b) {
    for (int rep = 0; rep < NREP(1); ++rep) {
      if (PH(1)) phase_inproj(p, b, vb, G, smem);
      GSYNC();
    }
    for (int rep = 0; rep < NREP(2); ++rep) {
      if (PH(2)) phase_prep(p, b, vb, G, smem);
      GSYNC();
    }
    for (int rep = 0; rep < NREP(3); ++rep) {
      if (PH(3)) phase_mlstm_u(p, vb, G, smem);
      GSYNC();
      if (PH(4)) phase_mlstm_scan(p, vb, G);
      GSYNC();
    }
    for (int rep = 0; rep < NREP(5); ++rep) {
      for (int t = vb; t < 512; t += G) { if (PH(5)) attn_task(p, t, smem); }
    }
    for (int rep = 0; rep < NREP(6); ++rep) {
      for (int t = vb; t < 256; t += G) { if (PH(6)) mlstm_out_task(p, t, smem); }
    }
    GSYNC();
    for (int rep = 0; rep < NREP(7); ++rep) {
      if (PH(7)) phase_merge(p, vb, G, smem);
      GSYNC();
      if (PH(8)) phase_outproj(p, b, vb, G, smem);
      GSYNC();
    }
  }
  for (int t = vb; t < NB * SEQ / 8; t += G) {
    const int R0 = t * 8 + wid * 2, b = R0 >> 13;
    const float* md = p.mod + b * 6144;
    norm_row2(p.out + (size_t)R0 * DM, p.out + (size_t)(R0 + 1) * DM, p.norm2, md + 3072, md + 4096, md + 3072, md + 4096, p.xn2 + (size_t)R0 * DM, p.xn2 + (size_t)(R0 + 1) * DM);
  }
  GSYNC();
  for (int rep = 0; rep < NREP(9); ++rep) {
    if (PH(9)) phase_ffn_in<0>(p, vb, G, smem);
    GSYNC();
  }

  if (PH(10)) phase_ffn_out(p, vb, G, smem);
}

extern "C" void kernel_launch(void* const* d_in, const int* in_sizes, int n_in, void* d_out, int out_size, void* d_ws, size_t ws_size,
                              hipStream_t stream) {
  static int grid_blocks = 0;
  if (!grid_blocks) {
    int dev = 0, cus = 0, per_cu = 0;
    (void)hipGetDevice(&dev);
    (void)hipDeviceGetAttribute(&cus, hipDeviceAttributeMultiprocessorCount, dev);
    (void)hipOccupancyMaxActiveBlocksPerMultiprocessor(&per_cu, hybrid_block_megakernel, 256, 0);
    if (per_cu > 1) per_cu = 1;
    grid_blocks = cus * per_cu;
  }
  Params p{};
  const float* const* in = (const float* const*)d_in;
  p.x = in[0]; p.c = in[1]; p.ctx = in[2]; p.c_ctx = in[3]; p.w_mod = in[4]; p.b_mod = in[5]; p.norm1 = in[6]; p.norm2 = in[7];
  p.w_in = in[8]; p.b_gate = in[9]; p.conv_w = in[10]; p.conv_b = in[11]; p.mlstm_norm = in[12]; p.q_norm = in[13]; p.k_norm = in[14];
  p.lam_vecs = in[15]; p.diff_norm = in[16]; p.w_a = in[17]; p.w_b = in[18]; p.w_out = in[19]; p.w_ffn_in = in[20]; p.w_ffn_out = in[21];
  p.out = (float*)d_out;
  unsigned char* ws = (unsigned char*)d_ws;
  size_t off = 0;
  auto take = [&](size_t bytes) { unsigned char* r = ws + off; off += (bytes + 255) & ~(size_t)255; return r; };
  p.bar = (unsigned*)take((size_t)XCD_BAR_WORDS * 4);
  (void)hipMemsetAsync(p.bar, 0, (size_t)XCD_BAR_WORDS * 4, stream);
  p.WinT = (bf16_t*)take((size_t)NWIN * 1024 * 2);
  p.WaT = (bf16_t*)take((size_t)1024 * 1024 * 2);
  p.WbT = (bf16_t*)take((size_t)1024 * 1024 * 2);
  p.WoT = (bf16_t*)take((size_t)1024 * 1024 * 2);
  p.WfiT = (bf16_t*)take((size_t)2 * FH * 1024 * 2);
  p.WfoT = (bf16_t*)take((size_t)1024 * FH * 2);
  p.mod = (float*)take((size_t)5 * 6144 * 4);
  p.rope = (float*)take((size_t)128 * 16 * 2 * 4);
  p.xn = (bf16_t*)take((size_t)NB * TB * DM * 2);
  const size_t r0 = off;
  p.P = (bf16_t*)take((size_t)TB * PLD * 2);
  p.gates = (float*)take((size_t)TB * 16 * 4);
  p.Qm = (bf16_t*)take((size_t)TB * 512 * 2);
  p.Km = (bf16_t*)take((size_t)TB * 512 * 2);
  p.KTm = (bf16_t*)take((size_t)512 * TB * 2);
  p.VTm = (bf16_t*)take((size_t)1024 * TB * 2);
  p.Qd = (bf16_t*)take((size_t)SEQ * 1024 * 2);
  p.Kd = (bf16_t*)take((size_t)TB * 1024 * 2);
  p.VTd = (bf16_t*)take((size_t)1024 * TB * 2);
  p.scal = (float*)take((size_t)8 * NSTEP * 256 * 4 * 4);
  p.stepsc = (float*)take((size_t)8 * NSTEP * 2 * 4);
  p.ST = (bf16_t*)take((size_t)8 * NSTEP * STROWS * 128 * 2);
  p.hA = (bf16_t*)take((size_t)SEQ * 1024 * 2);
  p.hB = (bf16_t*)take((size_t)SEQ * 1024 * 2);
  p.y = (bf16_t*)take((size_t)SEQ * 1024 * 2);
  p.xn2 = (bf16_t*)(ws + r0);
  p.hid = (bf16_t*)(ws + r0 + (size_t)NB * SEQ * DM * 2);
  if (off > ws_size || r0 + (size_t)NB * SEQ * DM * 2 + (size_t)NB * SEQ * FH * 2 > ws_size) fprintf(stderr, "workspace too small: need %zu have %zu\n", off, ws_size);
  void* args[] = {&p};
  hipError_t e = hipLaunchCooperativeKernel((void*)hybrid_block_megakernel, dim3(grid_blocks), dim3(256), args, 0, stream);
  if (e != hipSuccess) fprintf(stderr, "cooperative launch failed: %s (grid %d)\n", hipGetErrorString(e), grid_blocks);
}
```

```cpp
#include <hip/hip_runtime.h>
#include <hip/hip_cooperative_groups.h>
#include <cstdio>
#include <cstdint>
namespace cg = cooperative_groups;

#define DI __device__ __forceinline__
typedef unsigned short bf16_t;
typedef short bf16x8 __attribute__((ext_vector_type(8)));
typedef short bf16x4 __attribute__((ext_vector_type(4)));
typedef float f32x2 __attribute__((ext_vector_type(2)));
typedef float f32x4 __attribute__((ext_vector_type(4)));
typedef float f32x16 __attribute__((ext_vector_type(16)));
typedef unsigned u32x2 __attribute__((ext_vector_type(2)));
typedef unsigned u32x4 __attribute__((ext_vector_type(4)));
typedef __bf16 bfv2 __attribute__((ext_vector_type(2)));

constexpr int DM = 1024, NB = 4, SEQ = 8192, CTXL = 256, TB = SEQ + CTXL;
constexpr int PW = 8192;
constexpr int PLD = PW + 64;
constexpr int NWIN = 8448;
constexpr int FH = 2816;
constexpr int NSTEP = 33;
constexpr int STROWS = 288;
constexpr int SMEM_BYTES = 147456;

struct Params {
  const float *x, *c, *ctx, *c_ctx, *w_mod, *b_mod, *norm1, *norm2, *w_in, *b_gate, *conv_w, *conv_b, *mlstm_norm,
      *q_norm, *k_norm, *lam_vecs, *diff_norm, *w_a, *w_b, *w_out, *w_ffn_in, *w_ffn_out;
  float* out;
  bf16_t *WinT, *WaT, *WbT, *WoT, *WfiT, *WfoT;
  float *mod, *rope;
  bf16_t *xn, *P;
  float* gates;
  bf16_t *Qm, *Km, *KTm, *VTm, *Qd, *Kd, *VTd;
  float *scal, *stepsc;
  bf16_t *ST, *hA, *hB, *y, *xn2, *hid;
  unsigned* bar;
};

DI unsigned pk2(float a, float b) { f32x2 v = {a, b}; return __builtin_bit_cast(unsigned, __builtin_convertvector(v, bfv2)); }
DI bf16_t f2bf(float a) { return (bf16_t)(pk2(a, 0.f) & 0xffffu); }
DI float bf_lo(unsigned u) { return __uint_as_float(u << 16); }
DI float bf_hi(unsigned u) { return __uint_as_float(u & 0xffff0000u); }
DI float bf2f(bf16_t u) { return __uint_as_float(((unsigned)u) << 16); }
DI float siluf(float x) { return x * __builtin_amdgcn_rcpf(1.f + __expf(-x)); }
DI float sigmf(float x) { return __builtin_amdgcn_rcpf(1.f + __expf(-x)); }
DI f32x16 zero16() { f32x16 z; for (int i = 0; i < 16; ++i) z[i] = 0.f; return z; }
DI f32x4 zero4() { f32x4 z = {0.f, 0.f, 0.f, 0.f}; return z; }
#define MFMA32(a, b, c) __builtin_amdgcn_mfma_f32_32x32x16_bf16((a), (b), (c), 0, 0, 0)
#define MFMA16(a, b, c) __builtin_amdgcn_mfma_f32_16x16x32_bf16((a), (b), (c), 0, 0, 0)

DI bf16x8 pack8(const f32x16& x, int s) {
  u32x4 p;
  p[0] = pk2(x[8 * s + 0], x[8 * s + 1]); p[1] = pk2(x[8 * s + 2], x[8 * s + 3]);
  p[2] = pk2(x[8 * s + 4], x[8 * s + 5]); p[3] = pk2(x[8 * s + 6], x[8 * s + 7]);
  return __builtin_bit_cast(bf16x8, p);
}
DI bf16x8 cat4(u32x2 a, u32x2 b) { u32x4 p = {a[0], a[1], b[0], b[1]}; return __builtin_bit_cast(bf16x8, p); }

DI int srccol_win(int j) { if (j < 3072) return j; if (j < 8192) return j + 16; if (j < 8208) return 3072 + (j - 8192); return -1; }
DI int srccol_ffi(int r) { const int g = r >> 6, rr = r & 63; return rr < 32 ? g * 32 + rr : FH + g * 32 + (rr - 32); }

DI void wt_tile(const float* __restrict__ src, int ldsrc, int K, bf16_t* __restrict__ dst, int n0, int k0, int mode, bf16_t* sm) {
  const int t = threadIdx.x, nl = t & 63, kb = t >> 6;
  const int j = n0 + nl;
  const int sc = mode == 1 ? srccol_win(j) : (mode == 2 ? srccol_ffi(j) : j);
  float wv[16];
#pragma unroll
  for (int pss = 0; pss < 16; ++pss) wv[pss] = sc >= 0 ? src[(size_t)(k0 + kb + 4 * pss) * ldsrc + sc] : 0.f;
#pragma unroll
  for (int pss = 0; pss < 16; ++pss) sm[(kb + 4 * pss) * 66 + nl] = f2bf(wv[pss]);
  __syncthreads();
  const int n = t >> 2, ks = (t & 3) * 16;
  unsigned w[8];
#pragma unroll
  for (int i = 0; i < 8; ++i) w[i] = (unsigned)sm[(ks + 2 * i) * 66 + n] | ((unsigned)sm[(ks + 2 * i + 1) * 66 + n] << 16);
  u32x4* d = (u32x4*)(dst + (size_t)(n0 + n) * K + k0 + ks);
  d[0] = (u32x4){w[0], w[1], w[2], w[3]};
  d[1] = (u32x4){w[4], w[5], w[6], w[7]};
  __syncthreads();
}

DI void mod_task(const Params& p, int task, float* smf) {
  const int tid = threadIdx.x;
  for (int idx = tid; idx < 5 * 1024; idx += 256) {
    const int r = idx >> 10, k = idx & 1023;
    const float v = r < 4 ? p.c[r * 1024 + k] : p.c_ctx[k];
    smf[idx] = siluf(v);
  }
  __syncthreads();
  const int col = tid & 31, kg = tid >> 5, n = task * 32 + col;
  float acc[5] = {0.f, 0.f, 0.f, 0.f, 0.f};
#pragma unroll 32
  for (int k = kg * 128; k < kg * 128 + 128; ++k) {
    const float w = p.w_mod[(size_t)k * 6144 + n];
#pragma unroll
    for (int r = 0; r < 5; ++r) acc[r] += smf[r * 1024 + k] * w;
  }
  float* red = smf + 5120;
#pragma unroll
  for (int r = 0; r < 5; ++r) red[(kg * 32 + col) * 5 + r] = acc[r];
  __syncthreads();
  if (tid < 160) {
    const int r = tid >> 5, cc = tid & 31;
    float s = 0.f;
    for (int g = 0; g < 8; ++g) s += red[(g * 32 + cc) * 5 + r];
    p.mod[r * 6144 + task * 32 + cc] = s + p.b_mod[task * 32 + cc];
  }
  __syncthreads();
}

DI void phase0(const Params& p, int vb, int G, unsigned char* smem) {
  const int nWin = 132 * 16, nSq = 16 * 16, nFi = 88 * 16, nFo = 16 * 44;
  const int total = 193 + nWin + 3 * nSq + nFi + nFo;
  for (int t = vb; t < total; t += G) {
    if (t < 192) { mod_task(p, t, (float*)smem); continue; }
    if (t == 192) {
      for (int idx = threadIdx.x; idx < 128 * 16; idx += 256) {
        const int pos = idx >> 4, f = idx & 15;
        const float inv = exp2f(-(float)f * (13.287712379549449f / 16.0f));
        const float ang = (float)pos * inv;
        float rev = ang * 0.15915494309189535f; rev -= floorf(rev);
        p.rope[idx * 2 + 0] = __builtin_amdgcn_cosf(rev);
        p.rope[idx * 2 + 1] = __builtin_amdgcn_sinf(rev);
      }
      continue;
    }
    int u = t - 193;
    bf16_t* sm = (bf16_t*)smem;
    if (u < nWin) { wt_tile(p.w_in, 8208, 1024, p.WinT, (u >> 4) * 64, (u & 15) * 64, 1, sm); continue; }
    u -= nWin;
    if (u < nSq) { wt_tile(p.w_a, 1024, 1024, p.WaT, (u >> 4) * 64, (u & 15) * 64, 0, sm); continue; }
    u -= nSq;
    if (u < nSq) { wt_tile(p.w_b, 1024, 1024, p.WbT, (u >> 4) * 64, (u & 15) * 64, 0, sm); continue; }
    u -= nSq;
    if (u < nSq) { wt_tile(p.w_out, 1024, 1024, p.WoT, (u >> 4) * 64, (u & 15) * 64, 0, sm); continue; }
    u -= nSq;
    if (u < nFi) { wt_tile(p.w_ffn_in, 2 * FH, 1024, p.WfiT, (u >> 4) * 64, (u & 15) * 64, 2, sm); continue; }
    u -= nFi;
    wt_tile(p.w_ffn_out, 1024, FH, p.WfoT, (u / 44) * 64, (u % 44) * 64, 0, sm);
  }
}

DI void norm_row2(const float* __restrict__ srcA, const float* __restrict__ srcB, const float* __restrict__ gain, const float* __restrict__ shA, const float* __restrict__ scA,
                  const float* __restrict__ shB, const float* __restrict__ scB, bf16_t* __restrict__ dstA, bf16_t* __restrict__ dstB) {
  const int lane = threadIdx.x & 63;
  f32x4 va[4], vb2[4];
  float sa = 0.f, sb = 0.f;
#pragma unroll
  for (int i = 0; i < 4; ++i) { va[i] = *(const f32x4*)(srcA + (i * 64 + lane) * 4); vb2[i] = *(const f32x4*)(srcB + (i * 64 + lane) * 4); }
#pragma unroll
  for (int i = 0; i < 4; ++i) {
    sa += va[i][0] * va[i][0] + va[i][1] * va[i][1] + va[i][2] * va[i][2] + va[i][3] * va[i][3];
    sb += vb2[i][0] * vb2[i][0] + vb2[i][1] * vb2[i][1] + vb2[i][2] * vb2[i][2] + vb2[i][3] * vb2[i][3];
  }
#pragma unroll
  for (int o = 32; o >= 1; o >>= 1) { sa += __shfl_xor(sa, o); sb += __shfl_xor(sb, o); }
  const float ra = rsqrtf(sa * (1.0f / 1024.0f) + 1e-6f), rb = rsqrtf(sb * (1.0f / 1024.0f) + 1e-6f);
#pragma unroll
  for (int i = 0; i < 4; ++i) {
    const int k = (i * 64 + lane) * 4;
    const f32x4 g = *(const f32x4*)(gain + k);
    const f32x4 a1 = *(const f32x4*)(scA + k), a0 = *(const f32x4*)(shA + k), b1 = *(const f32x4*)(scB + k), b0 = *(const f32x4*)(shB + k);
    float oa[4], ob[4];
#pragma unroll
    for (int r = 0; r < 4; ++r) { oa[r] = va[i][r] * ra * g[r] * (1.f + a1[r]) + a0[r]; ob[r] = vb2[i][r] * rb * g[r] * (1.f + b1[r]) + b0[r]; }
    *(u32x2*)(dstA + k) = (u32x2){pk2(oa[0], oa[1]), pk2(oa[2], oa[3])};
    *(u32x2*)(dstB + k) = (u32x2){pk2(ob[0], ob[1]), pk2(ob[2], ob[3])};
  }
}

template <int NJ, bool SWAP = false>
DI void gemm_kloop(const bf16_t* __restrict__ A, int lda, const bf16_t* __restrict__ Bt, int ldb, int K, f32x16 (&acc)[4][NJ / 2], unsigned char* smem) {
  constexpr int BN = 32 * NJ, NBQ = BN / 32, NSL = 8 + NBQ, QPS = (NSL + 3) / 4, BUF = (256 + BN) * 72;
  int tid = threadIdx.x; asm volatile("" : "+v"(tid));
  const int lane = tid & 63, wid = tid >> 6, wm = wid >> 1, wn = wid & 1;
  const int l32 = lane & 31, hh = lane >> 5;
  const int lr = tid >> 3, lc = (tid & 7) * 8;
  const bf16_t* ap = A + (size_t)lr * lda + lc;
  const bf16_t* bp = Bt + (size_t)lr * ldb + lc;
  bf16_t* s0 = (bf16_t*)smem;
  u32x4 rg[NSL];
  const int nk = K >> 6;
#define SL_LOAD(Q, KT) do { if ((Q) < 8) rg[Q] = *(const u32x4*)(ap + (KT) * 64 + (size_t)(Q) * 32 * lda); \
                            else rg[Q] = *(const u32x4*)(bp + (KT) * 64 + (size_t)((Q) - 8) * 32 * ldb); } while (0)
#define SL_STORE(Q, BASE) do { if ((Q) < 8) *(u32x4*)((BASE) + (lr + 32 * (Q)) * 72 + lc) = rg[Q]; \
                               else *(u32x4*)((BASE) + 256 * 72 + (lr + 32 * ((Q) - 8)) * 72 + lc) = rg[Q]; } while (0)
#pragma unroll
  for (int q = 0; q < NSL; ++q) SL_LOAD(q, 0);
#pragma unroll
  for (int q = 0; q < NSL; ++q) SL_STORE(q, s0);
  {
    const int k1 = nk > 1 ? 1 : 0;
#pragma unroll
    for (int q = 0; q < NSL; ++q) SL_LOAD(q, k1);
  }
  __syncthreads();
#pragma unroll 1
  for (int kt = 0; kt < nk; ++kt) {
    const bf16_t* sa = s0 + (kt & 1) * BUF; const bf16_t* sb = sa + 256 * 72;
    bf16_t* so = s0 + ((kt & 1) ^ 1) * BUF;
    const int k2 = kt + 2 < nk ? kt + 2 : nk - 1;
    bf16x8 af[2][4], bfr[2][NJ / 2];
#pragma unroll
    for (int i = 0; i < 4; ++i) af[0][i] = *(const bf16x8*)(sa + (wm * 128 + i * 32 + l32) * 72 + hh * 8);
#pragma unroll
    for (int j = 0; j < NJ / 2; ++j) bfr[0][j] = *(const bf16x8*)(sb + (wn * 16 * NJ + j * 32 + l32) * 72 + hh * 8);
#pragma unroll
    for (int ks = 0; ks < 4; ++ks) {
      if (ks < 3) {
#pragma unroll
        for (int i = 0; i < 4; ++i) af[(ks + 1) & 1][i] = *(const bf16x8*)(sa + (wm * 128 + i * 32 + l32) * 72 + (ks + 1) * 16 + hh * 8);
#pragma unroll
        for (int j = 0; j < NJ / 2; ++j) bfr[(ks + 1) & 1][j] = *(const bf16x8*)(sb + (wn * 16 * NJ + j * 32 + l32) * 72 + (ks + 1) * 16 + hh * 8);
      }
#pragma unroll
      for (int q = ks * QPS; q < (ks + 1) * QPS && q < NSL; ++q) { SL_STORE(q, so); SL_LOAD(q, k2); }
#pragma unroll
      for (int i = 0; i < 4; ++i)
#pragma unroll
        for (int j = 0; j < NJ / 2; ++j) acc[i][j] = SWAP ? MFMA32(af[ks & 1][i], bfr[ks & 1][j], acc[i][j]) : MFMA32(bfr[ks & 1][j], af[ks & 1][i], acc[i][j]);
#pragma unroll
      for (int g = 0; g < 4 * (NJ / 2); ++g) {
        __builtin_amdgcn_sched_group_barrier(0x008, 1, 0);
        if (ks < 3 && g < 4 + NJ / 2) __builtin_amdgcn_sched_group_barrier(0x100, 1, 0);
        if (g < QPS) { __builtin_amdgcn_sched_group_barrier(0x200, 1, 0); __builtin_amdgcn_sched_group_barrier(0x020, 1, 0); }
      }
      __builtin_amdgcn_sched_barrier(0);
    }
    __syncthreads();
  }
#undef SL_LOAD
#undef SL_STORE
}
template <int NJ2>
DI void acc_zero(f32x16 (&acc)[4][NJ2]) {
#pragma unroll
  for (int i = 0; i < 4; ++i)
#pragma unroll
    for (int j = 0; j < NJ2; ++j) acc[i][j] = zero16();
}
#define EPI_COORDS(NJ) int tid = threadIdx.x; asm volatile("" : "+v"(tid)); const int lane = tid & 63, wid = tid >> 6, wm = wid >> 1, wn = wid & 1, l32 = lane & 31, hh = lane >> 5
DI void tile_map(int t, int NTn, int GM, int& mt, int& nt) { const int per = GM * NTn, g = t / per, r = t % per; mt = g * GM + r % GM; nt = r / GM; }

DI void phase_inproj(const Params& p, int b, int vb, int G, unsigned char* smem) {
  EPI_COORDS(4);
  const int MT = 33, NTn = 66;
  const bf16_t* A = p.xn + (size_t)b * TB * DM;
  for (int t = vb; t < MT * NTn; t += G) {
    int mt, nt; tile_map(t, NTn, 3, mt, nt);
    const int reg = nt >> 3;
    if (nt == 65 || (mt == 32 && (reg == 2 || reg == 3 || reg == 6 || reg == 7))) continue;
    if (nt < 65 && (reg == 1 || reg == 5)) {
      f32x16 acc[4][2]; acc_zero(acc);
      gemm_kloop<4, true>(A + (size_t)mt * 256 * DM, DM, p.WinT + (size_t)nt * 128 * DM, DM, DM, acc, smem);
      bf16_t* dstT = reg == 1 ? p.VTm : p.VTd;
      bf16_t* sT2 = (bf16_t*)smem;
#pragma unroll
      for (int i = 0; i < 4; ++i)
#pragma unroll
        for (int j = 0; j < 2; ++j)
#pragma unroll
          for (int r4 = 0; r4 < 4; ++r4)
            *(u32x2*)(sT2 + (wn * 64 + j * 32 + l32) * 264 + wm * 128 + i * 32 + 8 * r4 + 4 * hh) =
                (u32x2){pk2(acc[i][j][4 * r4], acc[i][j][4 * r4 + 1]), pk2(acc[i][j][4 * r4 + 2], acc[i][j][4 * r4 + 3])};
      __syncthreads();
      {
        const int rrow = tid >> 5, ch = tid & 31;
        bf16_t* dbase = dstT + (size_t)((nt & 7) * 128) * TB + mt * 256 + ch * 8;
#pragma unroll 2
        for (int q = 0; q < 16; ++q) {
          const int row = rrow + 8 * q;
          *(u32x4*)(dbase + (size_t)row * TB) = *(const u32x4*)(sT2 + row * 264 + ch * 8);
        }
      }
      __syncthreads();
      continue;
    }
    f32x16 acc[4][2]; acc_zero(acc);
    gemm_kloop<4>(A + (size_t)mt * 256 * DM, DM, p.WinT + (size_t)nt * 128 * DM, DM, DM, acc, smem);
    if (reg == 3 || reg == 4) {
      const bool isq = reg == 3;
      if (isq && mt == 32) continue;
      const float* gn = isq ? p.q_norm : p.k_norm;
      bf16_t* dst = isq ? p.Qd : p.Kd;
      const int c0 = (nt & 7) * 128 + wn * 64;
      const float osc = isq ? 0.125f * 1.4426950408889634f : 1.0f;
#pragma unroll
      for (int i = 0; i < 4; ++i) {
        const int tau = mt * 256 + wm * 128 + i * 32 + l32;
        float ss = 0.f;
#pragma unroll
        for (int j = 0; j < 2; ++j)
#pragma unroll
          for (int r = 0; r < 16; ++r) ss += acc[i][j][r] * acc[i][j][r];
        ss += __shfl_xor(ss, 32);
        const float rstd = rsqrtf(ss * (1.0f / 64.0f) + 1e-6f);
#pragma unroll
        for (int j = 0; j < 2; ++j) {
          float v[16];
#pragma unroll
          for (int r4 = 0; r4 < 4; ++r4) {
            const f32x4 g4 = *(const f32x4*)(gn + j * 32 + 8 * r4 + 4 * hh);
#pragma unroll
            for (int r = 0; r < 4; ++r) v[4 * r4 + r] = acc[i][j][4 * r4 + r] * rstd * g4[r];
          }
          if (mt < 32) {
            const int pos = j == 0 ? (tau >> 6) : (tau & 63);
            const float* rp = p.rope + pos * 32;
#pragma unroll
            for (int r4 = 0; r4 < 2; ++r4) {
              const f32x4 cs0 = *(const f32x4*)(rp + 2 * (8 * r4 + 4 * hh)), cs1 = *(const f32x4*)(rp + 2 * (8 * r4 + 4 * hh) + 4);
              const float cs[8] = {cs0[0], cs0[1], cs0[2], cs0[3], cs1[0], cs1[1], cs1[2], cs1[3]};
#pragma unroll
              for (int r = 0; r < 4; ++r) {
                const float x1 = v[4 * r4 + r], x2 = v[4 * (r4 + 2) + r], c = cs[2 * r], sn = cs[2 * r + 1];
                v[4 * r4 + r] = x1 * c - x2 * sn; v[4 * (r4 + 2) + r] = x2 * c + x1 * sn;
              }
            }
          }
#pragma unroll
          for (int r4 = 0; r4 < 4; ++r4)
            *(u32x2*)((bf16_t*)smem + (wm * 128 + i * 32 + l32) * 136 + wn * 64 + j * 32 + 8 * r4 + 4 * hh) = (u32x2){pk2(v[4 * r4] * osc, v[4 * r4 + 1] * osc), pk2(v[4 * r4 + 2] * osc, v[4 * r4 + 3] * osc)};
        }
      }
      __syncthreads();
      {
        const int rrow = tid >> 4, ch = tid & 15;
        bf16_t* dbase = dst + (size_t)(mt * 256) * 1024 + (nt & 7) * 128 + ch * 8;
#pragma unroll 2
        for (int q = 0; q < 16; ++q) {
          const int row = rrow + 16 * q;
          *(u32x4*)(dbase + (size_t)row * 1024) = *(const u32x4*)((const bf16_t*)smem + row * 136 + ch * 8);
        }
      }
      __syncthreads();
      continue;
    }
    bf16_t* sT = (bf16_t*)smem;
    if (nt < 64) {
#pragma unroll
      for (int i = 0; i < 4; ++i)
#pragma unroll
        for (int j = 0; j < 2; ++j)
#pragma unroll
          for (int r4 = 0; r4 < 4; ++r4)
            *(u32x2*)(sT + (wm * 128 + i * 32 + l32) * 136 + wn * 64 + j * 32 + 8 * r4 + 4 * hh) =
                (u32x2){pk2(acc[i][j][4 * r4], acc[i][j][4 * r4 + 1]), pk2(acc[i][j][4 * r4 + 2], acc[i][j][4 * r4 + 3])};
      __syncthreads();
      {
        const int rrow = tid >> 4, ch = tid & 15;
        bf16_t* dbase = p.P + (size_t)(mt * 256) * PLD + nt * 128 + ch * 8;
#pragma unroll 2
        for (int q = 0; q < 16; ++q) {
          const int row = rrow + 16 * q;
          *(u32x4*)(dbase + (size_t)row * PLD) = *(const u32x4*)(sT + row * 136 + ch * 8);
        }
      }
      if (reg != 0) { __syncthreads(); continue; }
    }
    if (reg == 0) {
      const int cg = tid & 31, tg = tid >> 5, c0 = nt * 128 + cg * 4, t0 = tg * 32;
      float w[5][4], bias[4];
#pragma unroll
      for (int j = 0; j < 5; ++j) {
        const f32x4 a0 = *(const f32x4*)(p.conv_w + j * 1024 + c0);
#pragma unroll
        for (int e = 0; e < 4; ++e) w[j][e] = a0[e];
      }
      {
        const f32x4 a0 = *(const f32x4*)(p.conv_b + c0);
#pragma unroll
        for (int e = 0; e < 4; ++e) bias[e] = a0[e];
      }
      const float osc = nt < 4 ? 0.08838834764831845f : 1.0f;
      float win[5][4];
#pragma unroll
      for (int j = 0; j < 4; ++j) {
        int rr = t0 - 2 + j; rr = rr < 0 ? 0 : rr;
        const u32x2 v = *(const u32x2*)(sT + rr * 136 + cg * 4);
        win[j + 1][0] = bf_lo(v[0]); win[j + 1][1] = bf_hi(v[0]); win[j + 1][2] = bf_lo(v[1]); win[j + 1][3] = bf_hi(v[1]);
      }
      unsigned outp[4][4];
#pragma unroll
      for (int tt = 0; tt < 32; ++tt) {
#pragma unroll
        for (int j = 0; j < 4; ++j)
#pragma unroll
          for (int e = 0; e < 4; ++e) win[j][e] = win[j + 1][e];
        int rr = t0 + tt + 2; rr = rr > 255 ? 255 : rr;
        const u32x2 v = *(const u32x2*)(sT + rr * 136 + cg * 4);
        win[4][0] = bf_lo(v[0]); win[4][1] = bf_hi(v[0]); win[4][2] = bf_lo(v[1]); win[4][3] = bf_hi(v[1]);
        float o[4];
#pragma unroll
        for (int e = 0; e < 4; ++e) {
          float a = bias[e];
#pragma unroll
          for (int j = 0; j < 5; ++j) a += win[j][e] * w[j][e];
          o[e] = siluf(a) * osc;
        }
        const int tau = mt * 256 + t0 + tt;
        const u32x2 pk = {pk2(o[0], o[1]), pk2(o[2], o[3])};
        if (nt < 4) *(u32x2*)(p.Qm + (size_t)tau * 512 + c0) = pk;
        else {
          *(u32x2*)(p.Km + (size_t)tau * 512 + (c0 - 512)) = pk;
#pragma unroll
          for (int e = 0; e < 4; ++e) {
            const unsigned hv = (e & 1) ? (pk[e >> 1] >> 16) : (pk[e >> 1] & 0xffffu);
            if (tt & 1) outp[e][(tt >> 1) & 3] |= hv << 16; else outp[e][(tt >> 1) & 3] = hv;
          }
          if ((tt & 7) == 7) {
#pragma unroll
            for (int e = 0; e < 4; ++e)
              *(u32x4*)(p.KTm + (size_t)(c0 - 512 + e) * TB + mt * 256 + t0 + (tt & 24)) = (u32x4){outp[e][0], outp[e][1], outp[e][2], outp[e][3]};
          }
        }
      }
      __syncthreads();
    }
    if (nt == 64 && wn == 0) {
#pragma unroll
      for (int i = 0; i < 4; ++i) {
        const int m = mt * 256 + wm * 128 + i * 32 + l32;
#pragma unroll
        for (int r4 = 0; r4 < 2; ++r4) {
          const int gc = 8 * r4 + 4 * hh, type = gc >> 2;
          f32x4 o;
#pragma unroll
          for (int r = 0; r < 4; ++r) {
            float g = acc[i][0][4 * r4 + r] + p.b_gate[gc + r];
            if (type & 1) g = fminf(g, 0.f) - __logf(1.f + __expf(-fabsf(g)));
            o[r] = g;
          }
          *(f32x4*)(p.gates + (size_t)m * 16 + gc) = o;
        }
      }
    }
  }
}

DI void load16(const bf16_t* src, float (&v)[16]) {
  const u32x4 a = *(const u32x4*)src, b2 = *(const u32x4*)(src + 8);
#pragma unroll
  for (int i = 0; i < 4; ++i) { v[2 * i] = bf_lo(a[i]); v[2 * i + 1] = bf_hi(a[i]); v[8 + 2 * i] = bf_lo(b2[i]); v[8 + 2 * i + 1] = bf_hi(b2[i]); }
}
DI void store16(bf16_t* dst, const float (&v)[16]) {
  u32x4 a, b2;
#pragma unroll
  for (int i = 0; i < 4; ++i) { a[i] = pk2(v[2 * i], v[2 * i + 1]); b2[i] = pk2(v[8 + 2 * i], v[8 + 2 * i + 1]); }
  *(u32x4*)dst = a; *(u32x4*)(dst + 8) = b2;
}
DI void tile_transpose_store(bf16_t* sm, const float (&v)[16], bf16_t* dstT, size_t ld, int col0, int tok0) {
  int tid = threadIdx.x; asm volatile("" : "+v"(tid));
  const int r = tid >> 2, seg = tid & 3;
#pragma unroll
  for (int i = 0; i < 16; ++i) sm[r * 66 + seg * 16 + i] = f2bf(v[i]);
  __syncthreads();
  const int col = tid >> 2, ts = (tid & 3) * 16;
  unsigned w[8];
#pragma unroll
  for (int i = 0; i < 8; ++i) w[i] = (unsigned)sm[(ts + 2 * i) * 66 + col] | ((unsigned)sm[(ts + 2 * i + 1) * 66 + col] << 16);
  u32x4* d = (u32x4*)(dstT + (size_t)(col0 + col) * ld + tok0 + ts);
  d[0] = (u32x4){w[0], w[1], w[2], w[3]};
  d[1] = (u32x4){w[4], w[5], w[6], w[7]};
  __syncthreads();
}

DI void scan_step(const Params& p, int chain, int i, float m, bool finalize, float& BL_out, float& pmax_out) {
  int tidl = threadIdx.x; asm volatile("" : "+v"(tidl));
  const int lane = tidl & 63, h = chain >> 1, dir = chain & 1;
  const int gi = (dir ? 8 : 0) + h, gf = (dir ? 12 : 4) + h;
  const int tau0 = i == 0 ? SEQ : (dir ? (32 - i) * 256 : (i - 1) * 256);
  float ig[4], B[4], a[4], pm[4];
  float run = 0.f;
#pragma unroll
  for (int r = 0; r < 4; ++r) {
    const int j = 4 * lane + r, pos = dir ? 255 - j : j;
    const float* g = p.gates + (size_t)(tau0 + pos) * 16;
    ig[r] = g[gi]; run += g[gf]; B[r] = run;
  }
  float inc = run;
#pragma unroll
  for (int o = 1; o < 64; o <<= 1) { const float t = __shfl_up(inc, o); if (lane >= o) inc += t; }
  const float excl = inc - run;
  const float BL = __shfl(inc, 63);
  float rmax = -3.0e38f;
#pragma unroll
  for (int r = 0; r < 4; ++r) { B[r] += excl; a[r] = ig[r] - B[r]; rmax = fmaxf(rmax, a[r]); pm[r] = rmax; }
  float incm = rmax;
#pragma unroll
  for (int o = 1; o < 64; o <<= 1) { const float t = __shfl_up(incm, o); if (lane >= o) incm = fmaxf(incm, t); }
  float exm = __shfl_up(incm, 1); if (lane == 0) exm = -3.0e38f;
  const float pmax_all = __shfl(incm, 63);
  BL_out = BL; pmax_out = pmax_all;
  if (finalize) {
    const float g255 = fmaxf(m, pmax_all);
    float* sc = p.scal + (size_t)(chain * NSTEP + i) * 1024;
#pragma unroll
    for (int r = 0; r < 4; ++r) {
      const int j = 4 * lane + r, pos = dir ? 255 - j : j;
      const float gj = fmaxf(m, fmaxf(exm, pm[r]));
      f32x4 o = {a[r], gj, B[r] + gj, __expf(a[r] - g255)};
      *(f32x4*)(sc + pos * 4) = o;
    }
    if (lane == 0) { p.stepsc[(chain * NSTEP + i) * 2] = m; p.stepsc[(chain * NSTEP + i) * 2 + 1] = __expf(m - g255); }
  }
}
DI void scalar_scan_block(const Params& p, int chain, float* sm) {
  const int lane = threadIdx.x & 63, wid = threadIdx.x >> 6;
  __syncthreads();
  for (int i = wid; i < NSTEP; i += 4) {
    float BL, pm; scan_step(p, chain, i, 0.f, false, BL, pm);
    if (lane == 0) { sm[i] = BL; sm[64 + i] = pm; }
  }
  __syncthreads();
  float m = 0.f;
  for (int i = 0; i < NSTEP; ++i) {
    if ((i & 3) == wid) { float BL, pm; scan_step(p, chain, i, m, true, BL, pm); }
    m = sm[i] + fmaxf(m, sm[64 + i]);
  }
  __syncthreads();
}

DI void phase_prep(const Params& p, int b, int vb, int G, unsigned char* smem) {
  bf16_t* sm = (bf16_t*)smem;
  int tid = threadIdx.x; asm volatile("" : "+v"(tid));
  const int r = tid >> 2, seg = tid & 3;
  const int nA = 33, nB = 0, nC = 0, nD = 0, nE = 0;
  const int total = 8 + nA;
  for (int t = vb; t < total; t += G) {
    if (t < 8) { scalar_scan_block(p, t, (float*)smem); continue; }
    int u = t - 8;
    if (u < nA) {
      const int mtile = u, brow = tid >> 6, c0 = (tid & 63) * 16;
      const int tau = mtile * 256 + (brow < 2 ? brow : 252 + brow);
      const int lo = mtile < 32 ? 0 : SEQ, hi = mtile < 32 ? SEQ : TB;
      float acc[16];
#pragma unroll
      for (int i = 0; i < 16; ++i) acc[i] = p.conv_b[c0 + i];
#pragma unroll
      for (int j = 0; j < 5; ++j) {
        const int t2 = tau + j - 2;
        if (t2 >= lo && t2 < hi) {
          float xv[16]; load16(p.P + (size_t)t2 * PLD + c0, xv);
#pragma unroll
          for (int i = 0; i < 16; ++i) acc[i] += xv[i] * p.conv_w[j * 1024 + c0 + i];
        }
      }
      if (c0 < 512) {
#pragma unroll
        for (int i = 0; i < 16; ++i) acc[i] = siluf(acc[i]) * 0.08838834764831845f;
        store16(p.Qm + (size_t)tau * 512 + c0, acc);
      } else {
#pragma unroll
        for (int i = 0; i < 16; ++i) acc[i] = siluf(acc[i]);
        store16(p.Km + (size_t)tau * 512 + (c0 - 512), acc);
#pragma unroll
        for (int i = 0; i < 16; ++i) p.KTm[(size_t)(c0 - 512 + i) * TB + tau] = f2bf(acc[i]);
      }
      continue;
    }
    u -= nA;
    if (u < nB) {
      const int ct = u & 15, tt = u >> 4, tau = tt * 64 + r;
      float xv[16]; load16(p.P + (size_t)tau * PLD + 1024 + ct * 64 + seg * 16, xv);
      tile_transpose_store(sm, xv, p.VTm, TB, ct * 64, tt * 64);
      continue;
    }
    u -= nB;
    if (u < nC + nD) {
      const bool isq = u < nC;
      if (!isq) u -= nC;
      const int ct = u & 15, tt = u >> 4, tau = tt * 64 + r;
      float xv[16]; load16(p.P + (size_t)tau * PLD + (isq ? 3072 : 4096) + ct * 64 + seg * 16, xv);
      float ss = 0.f;
#pragma unroll
      for (int i = 0; i < 16; ++i) ss += xv[i] * xv[i];
      ss += __shfl_xor(ss, 1); ss += __shfl_xor(ss, 2);
      const float rstd = rsqrtf(ss * (1.0f / 64.0f) + 1e-6f);
      const float* gn = (isq ? p.q_norm : p.k_norm) + seg * 16;
#pragma unroll
      for (int i = 0; i < 16; ++i) xv[i] = xv[i] * rstd * gn[i];
      if (tt < 128) {
        const int pos = seg < 2 ? (tau >> 6) : (tau & 63);
        const float* rp = p.rope + pos * 32;
#pragma unroll
        for (int i = 0; i < 16; ++i) {
          const float other = __shfl_xor(xv[i], 1);
          const float cs = rp[2 * i], sn = rp[2 * i + 1];
          xv[i] = (seg & 1) ? xv[i] * cs + other * sn : xv[i] * cs - other * sn;
        }
      }
      if (isq) {
#pragma unroll
        for (int i = 0; i < 16; ++i) xv[i] *= 0.125f * 1.4426950408889634f;
        store16(p.Qd + (size_t)tau * 1024 + ct * 64 + seg * 16, xv);
      } else {
        store16(p.Kd + (size_t)tau * 1024 + ct * 64 + seg * 16, xv);
      }
      continue;
    }
    u -= nC + nD;
    {
      const int ct = u & 15, tt = u >> 4, tau = tt * 64 + r;
      float xv[16]; load16(p.P + (size_t)tau * PLD + 5120 + ct * 64 + seg * 16, xv);
      tile_transpose_store(sm, xv, p.VTd, TB, ct * 64, tt * 64);
    }
  }
}

DI void phase_mlstm_u(const Params& p, int vb, int G, unsigned char* smem) {
  bf16_t* sV = (bf16_t*)smem;
  bf16_t* sKT = (bf16_t*)(smem + 36864);
  float* sw = (float*)(smem + 36864 + 18432);
  int tid = threadIdx.x; asm volatile("" : "+v"(tid));
  const int lane = tid & 63, wid = tid >> 6, l32 = lane & 31, hh = lane >> 5;
  for (int t = vb; t < 8 * NSTEP; t += G) {
    const int chain = t / NSTEP, i = t % NSTEP, h = chain >> 1, dir = chain & 1;
    const int tau0 = i == 0 ? SEQ : (dir ? (32 - i) * 256 : (i - 1) * 256);
    bf16_t* dstS = p.ST + (size_t)t * (STROWS * 128);
    __syncthreads();
    sw[tid] = p.scal[((size_t)t * 256 + tid) * 4 + 3];
    f32x16 acc[4][2];
#pragma unroll
    for (int a = 0; a < 4; ++a) { acc[a][0] = zero16(); acc[a][1] = zero16(); }
    float nsum = 0.f;
    for (int st = 0; st < 4; ++st) {
      __syncthreads();
      {
        const int seg = tid & 7;
#pragma unroll
        for (int q = 0; q < 8; ++q) {
          const int e = (tid >> 3) + 32 * q;
          *(u32x4*)(sV + e * 72 + seg * 8) = *(const u32x4*)(p.VTm + (size_t)(h * 256 + e) * TB + tau0 + st * 64 + seg * 8);
        }
#pragma unroll
        for (int q = 0; q < 4; ++q) {
          const int d = (tid >> 3) + 32 * q;
          const u32x4 kv = *(const u32x4*)(p.KTm + (size_t)(h * 128 + d) * TB + tau0 + st * 64 + seg * 8);
          const float* wp = sw + st * 64 + seg * 8;
          u32x4 o;
#pragma unroll
          for (int z = 0; z < 4; ++z) o[z] = pk2(bf_lo(kv[z]) * wp[2 * z], bf_hi(kv[z]) * wp[2 * z + 1]);
          *(u32x4*)(sKT + d * 72 + seg * 8) = o;
        }
      }
      __syncthreads();
#pragma unroll
      for (int ks = 0; ks < 4; ++ks) {
        bf16x8 kf[4], vf[2];
#pragma unroll
        for (int a = 0; a < 4; ++a) kf[a] = *(const bf16x8*)(sKT + (a * 32 + l32) * 72 + ks * 16 + hh * 8);
#pragma unroll
        for (int e2 = 0; e2 < 2; ++e2) vf[e2] = *(const bf16x8*)(sV + ((wid + 4 * e2) * 32 + l32) * 72 + ks * 16 + hh * 8);
#pragma unroll
        for (int a = 0; a < 4; ++a)
#pragma unroll
          for (int e2 = 0; e2 < 2; ++e2) acc[a][e2] = MFMA32(kf[a], vf[e2], acc[a][e2]);
      }
      if (tid < 128) {
#pragma unroll 8
        for (int s = 0; s < 64; ++s) nsum += bf2f(sKT[tid * 72 + s]);
      }
    }
#pragma unroll
    for (int a = 0; a < 4; ++a)
#pragma unroll
      for (int e2 = 0; e2 < 2; ++e2) {
        const int e = (wid + 4 * e2) * 32 + l32;
#pragma unroll
        for (int i4 = 0; i4 < 4; ++i4) {
          const int d0 = a * 32 + 8 * i4 + 4 * hh;
          const f32x16& v = acc[a][e2];
          *(u32x2*)(dstS + (size_t)e * 128 + d0) = (u32x2){pk2(v[4 * i4], v[4 * i4 + 1]), pk2(v[4 * i4 + 2], v[4 * i4 + 3])};
        }
      }
    if (tid < 128) dstS[256 * 128 + tid] = f2bf(nsum);
    for (int idx = tid; idx < 31 * 128 / 2; idx += 256) ((unsigned*)(dstS + 257 * 128))[idx] = 0u;
  }
}

DI void phase_mlstm_scan(const Params& p, int vb, int G) {
  const int pairs = STROWS * 128 / 2;
  const int ntask = 8 * pairs / 256;
  for (int t = vb; t < ntask; t += G) {
    int tidl = threadIdx.x; asm volatile("" : "+v"(tidl));
    const int gidx = t * 256 + tidl;
    const int chain = gidx / pairs, e2 = gidx % pairs;
    unsigned* base = (unsigned*)(p.ST + (size_t)chain * NSTEP * (STROWS * 128)) + e2;
    unsigned u[NSTEP];
#pragma unroll
    for (int i = 0; i < NSTEP; ++i) u[i] = base[(size_t)i * pairs];
    float s0 = 0.f, s1 = 0.f;
#pragma unroll
    for (int i = 0; i < NSTEP; ++i) {
      const float dec = p.stepsc[(chain * NSTEP + i) * 2 + 1];
      base[(size_t)i * pairs] = pk2(s0, s1);
      s0 = dec * s0 + bf_lo(u[i]); s1 = dec * s1 + bf_hi(u[i]);
    }
  }
}

DI void mlstm_out_task(const Params& p, int task, unsigned char* smem) {
  const int half = task & 1, c = (task >> 1) & 31, h = task >> 6;
  bf16_t* sK = (bf16_t*)smem;
  bf16_t* sV = (bf16_t*)(smem + 17408);
  float* sA = (float*)(smem + 17408 + 36864);
  int tid = threadIdx.x; asm volatile("" : "+v"(tid));
  const int lane = tid & 63, wid = tid >> 6, l32 = lane & 31, hh = lane >> 5;
  const int qi = half * 4 + wid, pq = qi * 32 + l32, tq = c * 256 + pq;
  bf16x8 qf[8];
#pragma unroll
  for (int ks = 0; ks < 8; ++ks) qf[ks] = *(const bf16x8*)(p.Qm + (size_t)tq * 512 + h * 128 + ks * 16 + hh * 8);
  bf16_t* hrow = p.hA + (size_t)tq * 1024 + h * 256;
  f32x16 num[8];
#pragma unroll 1
  for (int dir = 0; dir < 2; ++dir) {
    const int chain = h * 2 + dir, i = dir ? 32 - c : c + 1, sbase = chain * NSTEP + i;
    const float* sc = p.scal + (size_t)sbase * 1024;
    const float m_prev = p.stepsc[sbase * 2];
    const float g_q = sc[pq * 4 + 1], mj_q = sc[pq * 4 + 2];
    __syncthreads();
    sA[tid] = sc[tid * 4];
    f32x16 dent = zero16();
#pragma unroll
    for (int eb = 0; eb < 8; ++eb) num[eb] = zero16();
    float rs = 0.f;
    const int st_lo = dir == 0 ? 0 : half * 2, st_hi = dir == 0 ? half * 2 + 1 : 3;
    u32x4 rk[4], rv[8];
    {
      const int seg = tid & 15, sg = tid & 7;
#pragma unroll
      for (int q = 0; q < 4; ++q) rk[q] = *(const u32x4*)(p.Km + (size_t)(c * 256 + st_lo * 64 + (tid >> 4) + 16 * q) * 512 + h * 128 + seg * 8);
#pragma unroll
      for (int q = 0; q < 8; ++q) rv[q] = *(const u32x4*)(p.VTm + (size_t)(h * 256 + (tid >> 3) + 32 * q) * TB + c * 256 + st_lo * 64 + sg * 8);
    }
#pragma unroll 1
    for (int st = st_lo; st <= st_hi; ++st) {
      __syncthreads();
      {
        const int seg = tid & 15, sg = tid & 7;
#pragma unroll
        for (int q = 0; q < 4; ++q) *(u32x4*)(sK + ((tid >> 4) + 16 * q) * 136 + seg * 8) = rk[q];
#pragma unroll
        for (int q = 0; q < 8; ++q) *(u32x4*)(sV + ((tid >> 3) + 32 * q) * 72 + sg * 8) = rv[q];
      }
      __syncthreads();
      {
        const int sn = st < st_hi ? st + 1 : st;
        const int seg = tid & 15, sg = tid & 7;
#pragma unroll
        for (int q = 0; q < 4; ++q) rk[q] = *(const u32x4*)(p.Km + (size_t)(c * 256 + sn * 64 + (tid >> 4) + 16 * q) * 512 + h * 128 + seg * 8);
#pragma unroll
        for (int q = 0; q < 8; ++q) rv[q] = *(const u32x4*)(p.VTm + (size_t)(h * 256 + (tid >> 3) + 32 * q) * TB + c * 256 + sn * 64 + sg * 8);
      }
#pragma unroll 1
      for (int sub = 0; sub < 2; ++sub) {
        const int ki = st * 2 + sub;
        const bool need = dir == 0 ? ki <= qi : ki >= qi;
        if (!need) continue;
        f32x16 S = zero16();
#pragma unroll
        for (int ks = 0; ks < 8; ++ks) {
          const bf16x8 a = *(const bf16x8*)(sK + (sub * 32 + l32) * 136 + ks * 16 + hh * 8);
          S = MFMA32(a, qf[ks], S);
        }
#pragma unroll
        for (int i4 = 0; i4 < 4; ++i4) {
          const f32x4 av = *(const f32x4*)(sA + ki * 32 + 8 * i4 + 4 * hh);
#pragma unroll
          for (int r = 0; r < 4; ++r) {
            const int sp = ki * 32 + 8 * i4 + 4 * hh + r;
            const bool ok = dir == 0 ? sp <= pq : sp >= pq;
            const float dm = ok ? __expf(av[r] - g_q) : 0.f;
            const float v = S[4 * i4 + r] * dm;
            S[4 * i4 + r] = v; rs += v;
          }
        }
        const bf16x8 pf0 = pack8(S, 0), pf1 = pack8(S, 1);
#pragma unroll
        for (int eb = 0; eb < 8; ++eb) {
          const bf16_t* vr = sV + (eb * 32 + l32) * 72 + sub * 32 + 4 * hh;
          const bf16x8 v0 = cat4(*(const u32x2*)(vr), *(const u32x2*)(vr + 8));
          const bf16x8 v1 = cat4(*(const u32x2*)(vr + 16), *(const u32x2*)(vr + 24));
          num[eb] = MFMA32(v0, pf0, num[eb]);
          num[eb] = MFMA32(v1, pf1, num[eb]);
        }
      }
    }
    const float inter = __expf(m_prev - g_q);
    const bf16_t* Cst = p.ST + (size_t)sbase * (STROWS * 128);
    {
      bf16x8 cf[2][8];
#pragma unroll
      for (int ks = 0; ks < 8; ++ks) cf[0][ks] = *(const bf16x8*)(Cst + (size_t)l32 * 128 + ks * 16 + hh * 8);
#pragma unroll
      for (int eb = 0; eb < 9; ++eb) {
        if (eb < 8) {
#pragma unroll
          for (int ks = 0; ks < 8; ++ks) cf[(eb + 1) & 1][ks] = *(const bf16x8*)(Cst + (size_t)((eb + 1) * 32 + l32) * 128 + ks * 16 + hh * 8);
        }
        f32x16 tmp = zero16();
#pragma unroll
        for (int ks = 0; ks < 8; ++ks) tmp = MFMA32(cf[eb & 1][ks], qf[ks], tmp);
        if (eb < 8) {
#pragma unroll
          for (int r = 0; r < 16; ++r) num[eb][r] += inter * tmp[r];
        } else {
          dent = tmp;
        }
        __builtin_amdgcn_sched_barrier(0);
      }
    }
    rs += __shfl_xor(rs, 32);
    const float dn = inter * __shfl(dent[0], l32);
    const float den = rs + dn;
    const float inv = 1.0f / fmaxf(fabsf(den), __expf(-mj_q));
    if (dir == 0) {
#pragma unroll
      for (int eb = 0; eb < 8; ++eb)
#pragma unroll
        for (int i4 = 0; i4 < 4; ++i4) {
          const f32x16& v = num[eb];
          *(u32x2*)(hrow + eb * 32 + 8 * i4 + 4 * hh) = (u32x2){pk2(v[4 * i4] * inv, v[4 * i4 + 1] * inv), pk2(v[4 * i4 + 2] * inv, v[4 * i4 + 3] * inv)};
        }
    } else {
#pragma unroll
      for (int eb = 0; eb < 8; ++eb)
#pragma unroll
        for (int i4 = 0; i4 < 4; ++i4) {
          const u32x2 st2 = *(const u32x2*)(hrow + eb * 32 + 8 * i4 + 4 * hh);
          num[eb][4 * i4 + 0] = bf_lo(st2[0]) + num[eb][4 * i4 + 0] * inv;
          num[eb][4 * i4 + 1] = bf_hi(st2[0]) + num[eb][4 * i4 + 1] * inv;
          num[eb][4 * i4 + 2] = bf_lo(st2[1]) + num[eb][4 * i4 + 2] * inv;
          num[eb][4 * i4 + 3] = bf_hi(st2[1]) + num[eb][4 * i4 + 3] * inv;
          if (i4 == 3) asm volatile("" ::: "memory");
        }
    }
  }
  float ss = 0.f;
#pragma unroll
  for (int eb = 0; eb < 8; ++eb)
#pragma unroll
    for (int r = 0; r < 16; ++r) ss += num[eb][r] * num[eb][r];
  ss += __shfl_xor(ss, 32);
  const float rstd = rsqrtf(ss * (1.0f / 256.0f) + 1e-6f);
  const bf16_t* morow = p.P + (size_t)tq * PLD + 2048 + h * 256;
#pragma unroll
  for (int eb = 0; eb < 8; ++eb)
#pragma unroll
    for (int i4 = 0; i4 < 4; ++i4) {
      const int e0 = eb * 32 + 8 * i4 + 4 * hh;
      const f32x4 gn = *(const f32x4*)(p.mlstm_norm + h * 256 + e0);
      const u32x2 mo = *(const u32x2*)(morow + e0);
      const float o0 = num[eb][4 * i4 + 0] * rstd * gn[0] * sigmf(bf_lo(mo[0]));
      const float o1 = num[eb][4 * i4 + 1] * rstd * gn[1] * sigmf(bf_hi(mo[0]));
      const float o2 = num[eb][4 * i4 + 2] * rstd * gn[2] * sigmf(bf_lo(mo[1]));
      const float o3 = num[eb][4 * i4 + 3] * rstd * gn[3] * sigmf(bf_hi(mo[1]));
      *(u32x2*)(hrow + e0) = (u32x2){pk2(o0, o1), pk2(o2, o3)};
      if ((i4 & 1) == 1) asm volatile("" ::: "memory");
    }
}

DI void attn_task(const Params& p, int task, unsigned char* smem) {
  const int h = task >> 6, qb = task & 63;
  bf16_t* sK = (bf16_t*)smem;
  int tid = threadIdx.x; asm volatile("" : "+v"(tid));
  const int lane = tid & 63, wid = tid >> 6, l32 = lane & 31, hh = lane >> 5;
  const int tq = qb * 128 + wid * 32 + l32;
  float lam, M2;
  {
    const float* lv = p.lam_vecs;
    float a = lv[lane] * lv[64 + lane], b2 = lv[128 + lane] * lv[192 + lane];
    float gq = fabsf(p.q_norm[lane]), gk = fabsf(p.k_norm[lane]);
#pragma unroll
    for (int o = 32; o >= 1; o >>= 1) { a += __shfl_xor(a, o); b2 += __shfl_xor(b2, o); gq = fmaxf(gq, __shfl_xor(gq, o)); gk = fmaxf(gk, __shfl_xor(gk, o)); }
    lam = __expf(a) - __expf(b2) + 0.2f;
    M2 = 8.0f * 1.4426950408889634f * gq * gk;
  }
  bf16x8 qf[2][4];
#pragma unroll
  for (int mp = 0; mp < 2; ++mp)
#pragma unroll
    for (int s = 0; s < 4; ++s) qf[mp][s] = *(const bf16x8*)(p.Qd + (size_t)tq * 1024 + h * 128 + mp * 64 + s * 16 + hh * 8);
  f32x16 O[2][4];
#pragma unroll
  for (int mp = 0; mp < 2; ++mp)
#pragma unroll
    for (int eb = 0; eb < 4; ++eb) O[mp][eb] = zero16();
  float ls0 = 0.f, ls1 = 0.f;
  f32x16 minit;
#pragma unroll
  for (int r = 0; r < 16; ++r) minit[r] = -M2;
  const int kr = tid >> 4, kseg = tid & 15, vr = tid >> 3, vseg = tid & 7;
  const bf16_t* kg = p.Kd + (size_t)kr * 1024 + h * 128 + kseg * 8;
  const bf16_t* vg = p.VTd + (size_t)(h * 128 + vr) * TB + vseg * 8;
  constexpr int ABUF = 64 * 136 + 128 * 72;
  u32x4 rg[8];
#define A_LOAD(Q, KT) do { if ((Q) < 4) rg[Q] = *(const u32x4*)(kg + (size_t)((KT) * 64 + 16 * (Q)) * 1024); \
                           else rg[Q] = *(const u32x4*)(vg + (size_t)(32 * ((Q) - 4)) * TB + (KT) * 64); } while (0)
#define A_STORE(Q, BASE) do { if ((Q) < 4) *(u32x4*)((BASE) + (kr + 16 * (Q)) * 136 + kseg * 8) = rg[Q]; \
                              else *(u32x4*)((BASE) + 64 * 136 + (vr + 32 * ((Q) - 4)) * 72 + vseg * 8) = rg[Q]; } while (0)
  const int NKT = TB / 64;
  __syncthreads();
#pragma unroll
  for (int q = 0; q < 8; ++q) A_LOAD(q, 0);
#pragma unroll
  for (int q = 0; q < 8; ++q) A_STORE(q, sK);
#pragma unroll
  for (int q = 0; q < 8; ++q) A_LOAD(q, 1);
  __syncthreads();
#pragma unroll 1
  for (int kt = 0; kt < NKT; ++kt) {
    const bf16_t* cK = sK + (kt & 1) * ABUF; const bf16_t* cV = cK + 64 * 136;
    bf16_t* so = sK + ((kt & 1) ^ 1) * ABUF;
    const int k2 = kt + 2 < NKT ? kt + 2 : NKT - 1;
#pragma unroll
    for (int sub = 0; sub < 2; ++sub) {
      bf16x8 pf[2][2];
#pragma unroll
      for (int mp = 0; mp < 2; ++mp) {
        f32x16 S = minit;
#pragma unroll
        for (int s = 0; s < 4; ++s) {
          const bf16x8 a = *(const bf16x8*)(cK + (sub * 32 + l32) * 136 + mp * 64 + s * 16 + hh * 8);
          S = MFMA32(a, qf[mp][s], S);
        }
        float l = 0.f;
#pragma unroll
        for (int r = 0; r < 16; ++r) { S[r] = __builtin_amdgcn_exp2f(S[r]); l += S[r]; }
        if (mp == 0) ls0 += l; else ls1 += l;
        pf[mp][0] = pack8(S, 0); pf[mp][1] = pack8(S, 1);
      }
#pragma unroll
      for (int q = sub * 4; q < sub * 4 + 4; ++q) { A_STORE(q, so); A_LOAD(q, k2); }
#pragma unroll
      for (int eb = 0; eb < 4; ++eb) {
        const bf16_t* vrp = cV + (eb * 32 + l32) * 72 + sub * 32 + 4 * hh;
        const bf16x8 v0 = cat4(*(const u32x2*)(vrp), *(const u32x2*)(vrp + 8));
        const bf16x8 v1 = cat4(*(const u32x2*)(vrp + 16), *(const u32x2*)(vrp + 24));
        O[0][eb] = MFMA32(v0, pf[0][0], O[0][eb]);
        O[1][eb] = MFMA32(v0, pf[1][0], O[1][eb]);
        O[0][eb] = MFMA32(v1, pf[0][1], O[0][eb]);
        O[1][eb] = MFMA32(v1, pf[1][1], O[1][eb]);
      }
    }
    __syncthreads();
  }
#undef A_LOAD
#undef A_STORE
  ls0 += __shfl_xor(ls0, 32); ls1 += __shfl_xor(ls1, 32);
  const float i0 = 1.0f / ls0, i1 = lam / ls1;
  float ss = 0.f;
#pragma unroll
  for (int eb = 0; eb < 4; ++eb)
#pragma unroll
    for (int r = 0; r < 16; ++r) { const float o = O[0][eb][r] * i0 - O[1][eb][r] * i1; O[0][eb][r] = o; ss += o * o; }
  ss += __shfl_xor(ss, 32);
  const float rstd = rsqrtf(ss * (1.0f / 128.0f) + 1e-6f) * 0.8f;
  bf16_t* orow = p.hB + (size_t)tq * 1024 + h * 128;
#pragma unroll
  for (int eb = 0; eb < 4; ++eb)
#pragma unroll
    for (int i4 = 0; i4 < 4; ++i4) {
      const int e0 = eb * 32 + 8 * i4 + 4 * hh;
      const f32x4 gn = *(const f32x4*)(p.diff_norm + e0);
      const f32x16& o = O[0][eb];
      *(u32x2*)(orow + e0) = (u32x2){pk2(o[4 * i4] * rstd * gn[0], o[4 * i4 + 1] * rstd * gn[1]), pk2(o[4 * i4 + 2] * rstd * gn[2], o[4 * i4 + 3] * rstd * gn[3])};
    }
}

DI void phase_merge(const Params& p, int vb, int G, unsigned char* smem) {
  EPI_COORDS(4);
  for (int t = vb; t < 32 * 8; t += G) {
    int mt, nt; tile_map(t, 8, 4, mt, nt);
    f32x16 acc[4][2];
    acc_zero(acc);
    gemm_kloop<4>(p.hA + (size_t)mt * 256 * DM, DM, p.WaT + (size_t)nt * 128 * DM, DM, DM, acc, smem);
#pragma unroll
    for (int i = 0; i < 4; ++i) {
      const int m = mt * 256 + wm * 128 + i * 32 + l32;
#pragma unroll
      for (int j = 0; j < 2; ++j)
#pragma unroll
        for (int r4 = 0; r4 < 4; ++r4) {
          const int n = nt * 128 + wn * 64 + j * 32 + 8 * r4 + 4 * hh;
          const u32x2 g = *(const u32x2*)(p.P + (size_t)m * PLD + 6144 + n);
          *(u32x2*)(p.y + (size_t)m * DM + n) = (u32x2){pk2(sigmf(bf_lo(g[0])) * acc[i][j][4 * r4 + 0], sigmf(bf_hi(g[0])) * acc[i][j][4 * r4 + 1]),
                                                        pk2(sigmf(bf_lo(g[1])) * acc[i][j][4 * r4 + 2], sigmf(bf_hi(g[1])) * acc[i][j][4 * r4 + 3])};
        }
    }
    acc_zero(acc);
    gemm_kloop<4>(p.hB + (size_t)mt * 256 * DM, DM, p.WbT + (size_t)nt * 128 * DM, DM, DM, acc, smem);
#pragma unroll
    for (int i = 0; i < 4; ++i) {
      const int m = mt * 256 + wm * 128 + i * 32 + l32;
#pragma unroll
      for (int j = 0; j < 2; ++j)
#pragma unroll
        for (int r4 = 0; r4 < 4; ++r4) {
          const int n = nt * 128 + wn * 64 + j * 32 + 8 * r4 + 4 * hh;
          const u32x2 g = *(const u32x2*)(p.P + (size_t)m * PLD + 7168 + n);
          const u32x2 y0 = *(const u32x2*)(p.y + (size_t)m * DM + n);
          const float o0 = bf_lo(y0[0]) + sigmf(bf_lo(g[0])) * acc[i][j][4 * r4 + 0], o1 = bf_hi(y0[0]) + sigmf(bf_hi(g[0])) * acc[i][j][4 * r4 + 1];
          const float o2 = bf_lo(y0[1]) + sigmf(bf_lo(g[1])) * acc[i][j][4 * r4 + 2], o3 = bf_hi(y0[1]) + sigmf(bf_hi(g[1])) * acc[i][j][4 * r4 + 3];
          *(u32x2*)(p.y + (size_t)m * DM + n) = (u32x2){pk2(o0, o1), pk2(o2, o3)};
        }
    }
  }
}

DI void phase_outproj(const Params& p, int b, int vb, int G, unsigned char* smem) {
  EPI_COORDS(4);
  for (int t = vb; t < 32 * 8; t += G) {
    int mt, nt; tile_map(t, 8, 4, mt, nt);
    f32x16 acc[4][2]; acc_zero(acc);
    gemm_kloop<4>(p.y + (size_t)mt * 256 * DM, DM, p.WoT + (size_t)nt * 128 * DM, DM, DM, acc, smem);
#pragma unroll
    for (int i = 0; i < 4; ++i) {
      const int m = mt * 256 + wm * 128 + i * 32 + l32;
      const size_t row = (size_t)(b * SEQ + m) * DM;
#pragma unroll
      for (int j = 0; j < 2; ++j)
#pragma unroll
        for (int r4 = 0; r4 < 4; ++r4) {
          const int n = nt * 128 + wn * 64 + j * 32 + 8 * r4 + 4 * hh;
          const f32x4 xv = *(const f32x4*)(p.x + row + n), g1 = *(const f32x4*)(p.mod + b * 6144 + 2048 + n);
          f32x4 o;
#pragma unroll
          for (int r = 0; r < 4; ++r) o[r] = xv[r] + g1[r] * acc[i][j][4 * r4 + r];
          *(f32x4*)(p.out + row + n) = o;
        }
    }
  }
}

template <int PROBE>
DI void phase_ffn_in(const Params& p, int vb, int G, unsigned char* smem) {
  EPI_COORDS(4);
  for (int t = vb; t < 128 * 44; t += G) {
    int mt, nt; tile_map(t, 44, 4, mt, nt);
    f32x16 acc[4][2]; acc_zero(acc);
    gemm_kloop<4>(p.xn2 + (size_t)(PROBE == 1 ? 0 : mt) * 256 * DM, DM, p.WfiT + (size_t)(PROBE == 1 ? 0 : nt) * 128 * DM, DM, DM, acc, smem);
#pragma unroll
    for (int i = 0; i < 4; ++i) {
      const int m = mt * 256 + wm * 128 + i * 32 + l32;
#pragma unroll
      for (int r4 = 0; r4 < 4; ++r4) {
        const int hc = (nt * 2 + wn) * 32 + 8 * r4 + 4 * hh;
        float o[4];
#pragma unroll
        for (int r = 0; r < 4; ++r) o[r] = siluf(acc[i][0][4 * r4 + r]) * acc[i][1][4 * r4 + r];
        bf16_t* hdst = PROBE ? p.hid + (size_t)NB * SEQ * FH + (size_t)(m & 8191) * FH : p.hid + (size_t)m * FH;
        *(u32x2*)(hdst + hc) = (u32x2){pk2(o[0], o[1]), pk2(o[2], o[3])};
      }
    }
  }
}

DI void phase_ffn_out(const Params& p, int vb, int G, unsigned char* smem) {
  EPI_COORDS(8);
  for (int t = vb; t < 128 * 4; t += G) {
    int mt, nt; tile_map(t, 4, 8, mt, nt);
    f32x16 acc[4][4]; acc_zero(acc);
    gemm_kloop<8>(p.hid + (size_t)mt * 256 * FH, FH, p.WfoT + (size_t)nt * 256 * FH, FH, FH, acc, smem);
#pragma unroll
    for (int i = 0; i < 4; ++i) {
      const int m = mt * 256 + wm * 128 + i * 32 + l32;
      const int b = m >> 13;
#pragma unroll
      for (int j = 0; j < 4; ++j)
#pragma unroll
        for (int r4 = 0; r4 < 4; ++r4) {
          const int n = nt * 256 + wn * 128 + j * 32 + 8 * r4 + 4 * hh;
          float* op = p.out + (size_t)m * DM + n;
          const f32x4 xv = *(const f32x4*)op, g2 = *(const f32x4*)(p.mod + b * 6144 + 5120 + n);
          f32x4 o;
#pragma unroll
          for (int r = 0; r < 4; ++r) o[r] = xv[r] + g2[r] * acc[i][j][4 * r4 + r];
          *(f32x4*)op = o;
        }
    }
  }
}

#define XB_TMO      128
#define XB_XCNT(j)  (256  + 64 * (j))
#define XB_XSUB(j)  (1280 + 64 * (j))
#define XB_XGEN(j)  (2304 + 64 * (j))
#define XB_TOP      3328
#define XB_TOPGEN   3392
#define XCD_BAR_WORDS 3456
#define XB_SPIN_CAP (1u << 22)
#define LAS __attribute__((address_space(3)))
DI unsigned xb_ld(unsigned* p) { return __hip_atomic_load(p, __ATOMIC_RELAXED, __HIP_MEMORY_SCOPE_AGENT); }
DI unsigned xb_add(unsigned* p, unsigned v) { return __hip_atomic_fetch_add(p, v, __ATOMIC_RELAXED, __HIP_MEMORY_SCOPE_AGENT); }
DI unsigned xb_xcc_id() { return (unsigned)__builtin_amdgcn_s_getreg((3 << 11) | 20) & 0xFu; }
#define XB_SPIN(cond, bar) do { unsigned _sp = 0; while (cond) { __builtin_amdgcn_s_sleep(1); \
    if ((++_sp & 255u) == 0u) { if (xb_ld(&(bar)[XB_TMO])) break; if (_sp > XB_SPIN_CAP) { atomicAdd(&(bar)[XB_TMO], 1u); break; } } } } while (0)
struct XcdBarrier { unsigned* bar; unsigned x; volatile LAS unsigned* st; };
DI XcdBarrier xcd_barrier_post(unsigned* bar, volatile LAS unsigned* st) {
  XcdBarrier b; b.bar = bar; b.x = xb_xcc_id(); b.st = st;
  if (threadIdx.x == 0) st[2] = xb_add(&bar[XB_XCNT(b.x)], 1u);
  return b;
}
DI void xcd_barrier_complete(unsigned* bar, unsigned x, unsigned& nloc, unsigned& nx) {
  const unsigned G = gridDim.x * gridDim.y * gridDim.z;
  unsigned sum, cnt, mine, sp = 0u;
  for (;;) {
    sum = 0u; cnt = 0u; mine = 0u;
#pragma unroll
    for (unsigned j = 0; j < 16; ++j) { const unsigned c = xb_ld(&bar[XB_XCNT(j)]); sum += c; cnt += (c > 0u) ? 1u : 0u; mine = (j == x) ? c : mine; }
    if (sum == G) break;
    __builtin_amdgcn_s_sleep(1);
    if ((++sp & 255u) == 0u) { if (xb_ld(&bar[XB_TMO])) break; if (sp > XB_SPIN_CAP) { atomicAdd(&bar[XB_TMO], 1u); break; } }
  }
  nloc = mine > 0u ? mine : 1u; nx = cnt > 0u ? cnt : 1u;
}
DI void xcd_barrier(const XcdBarrier& b) {
  asm volatile("s_waitcnt vmcnt(0)" ::: "memory");
  __syncthreads();
  if (threadIdx.x == 0) {
    unsigned* bar = b.bar;
    __builtin_amdgcn_s_waitcnt(0);
    unsigned nloc = b.st[0], nx = b.st[1];
    if (nloc == 0u) { xcd_barrier_complete(bar, b.x, nloc, nx); b.st[0] = nloc; b.st[1] = nx; }
    const unsigned old = xb_add(&bar[XB_XSUB(b.x)], 1u);
    const unsigned gen = old / nloc;
    if (old + 1u == (gen + 1u) * nloc) {
      __builtin_amdgcn_fence(__ATOMIC_RELEASE, "agent");
      asm volatile("s_waitcnt vmcnt(0)" ::: "memory");
      const unsigned og = xb_add(&bar[XB_TOP], 1u);
      const unsigned tg = og / nx;
      if (og + 1u == (tg + 1u) * nx) xb_add(&bar[XB_TOPGEN], 1u);
      else XB_SPIN(xb_ld(&bar[XB_TOPGEN]) == tg, bar);
      __builtin_amdgcn_fence(__ATOMIC_ACQUIRE, "agent");
      xb_add(&bar[XB_XGEN(b.x)], 1u);
      asm volatile("s_waitcnt vmcnt(0)" ::: "memory");
    } else {
      XB_SPIN(xb_ld(&bar[XB_XGEN(b.x)]) == gen, bar);
      __builtin_amdgcn_fence(__ATOMIC_ACQUIRE, "agent");
      asm volatile("s_waitcnt vmcnt(0)" ::: "memory");
    }
  }
  __syncthreads();
}

#ifndef PHMASK
#define PHMASK 0xFFFF
#endif
#define PH(n) ((PHMASK >> (n)) & 1)
#ifndef REPMASK
#define REPMASK 0
#endif
#define NREP(n) (1 + ((REPMASK >> (n)) & 1))
#define GSYNC() do { xcd_barrier(xb); if ((REPMASK >> 15) & 1) xcd_barrier(xb); } while (0)
__global__ void __launch_bounds__(256, 1) hybrid_block_megakernel(Params p) {
  cg::grid_group grid = cg::this_grid();
  __shared__ __attribute__((aligned(16))) unsigned char smem[SMEM_BYTES];
  const int G = gridDim.x, bid = blockIdx.x;
  int vb = bid;
  const int wid = threadIdx.x >> 6;
  __shared__ __attribute__((aligned(16))) unsigned xb_words[4];
  if (threadIdx.x < 4) xb_words[threadIdx.x] = 0u;
  __syncthreads();
  const XcdBarrier xb = xcd_barrier_post(p.bar, (volatile LAS unsigned*)xb_words);

  if (PH(0)) phase0(p, vb, G, smem);
  grid.sync();
  GSYNC();
  if (threadIdx.x == 0) {
    bool even = (G % 8) == 0 && xb.x < 8u;
    for (unsigned j = 0; j < 16; ++j) { const unsigned cnt = xb_ld(&p.bar[XB_XCNT(j)]); if (cnt != (j < 8u ? (unsigned)(G / 8) : 0u)) even = false; }
    xb_words[3] = even ? 1u : 0u;
  }
  __syncthreads();
  if (xb_words[3]) vb = (int)xb.x * (G / 8) + (int)xb_words[2];
  for (int t = vb; t < NB * TB / 8; t += G) {
    const int R0 = t * 8 + wid * 2;
    const float* src[2]; const float* md[2];
#pragma unroll
    for (int z = 0; z < 2; ++z) {
      const int R = R0 + z, b = R / TB, tau = R % TB;
      src[z] = tau < SEQ ? p.x + (size_t)(b * SEQ + tau) * DM : p.ctx + (size_t)(b * CTXL + tau - SEQ) * DM;
      md[z] = p.mod + (tau < SEQ ? b : 4) * 6144;
    }
    norm_row2(src[0], src[1], p.norm1, md[0], md[0] + 1024, md[1], md[1] + 1024, p.xn + (size_t)R0 * DM, p.xn + (size_t)(R0 + 1) * DM);
  }
  GSYNC();
  for (int b = 0; b < NB; ++b) {
    for (int rep = 0; rep < NREP(1); ++rep) {
      if (PH(1)) phase_inproj(p, b, vb, G, smem);
      GSYNC();
    }
    for (int rep = 0; rep < NREP(2); ++rep) {
      if (PH(2)) phase_prep(p, b, vb, G, smem);
      GSYNC();
    }
    for (int rep = 0; rep < NREP(3); ++rep) {
      if (PH(3)) phase_mlstm_u(p, vb, G, smem);
      GSYNC();
      if (PH(4)) phase_mlstm_scan(p, vb, G);
      GSYNC();
    }
    for (int rep = 0; rep < NREP(5); ++rep) {
      for (int t = vb; t < 512; t += G) { if (PH(5)) attn_task(p, t, smem); }
    }
    for (int rep = 0; rep < NREP(6); ++rep) {
      for (int t = vb; t < 256; t += G) { if (PH(6)) mlstm_out_task(p, t, smem); }
    }
    GSYNC();
    for (int rep = 0; rep < NREP(7); ++rep) {
      if (PH(7)) phase_merge(p, vb, G, smem);
      GSYNC();
      if (PH(8)) phase_outproj(p, b, vb, G, smem);
      GSYNC();
    }
  }
  for (int t = vb; t < NB * SEQ / 8; t += G) {
    const int R0 = t * 8 + wid * 2, b = R0 >> 13;
    const float* md = p.mod + b * 6144;
    norm_row2(p.out + (size_t)R0 * DM, p.out + (size_t)(R0 + 1) * DM, p.norm2, md + 3072, md + 4096, md + 3072, md + 4096, p.xn2 + (size_t)R0 * DM, p.xn2 + (size_t)(R0 + 1) * DM);
  }
  GSYNC();
  for (int rep = 0; rep < NREP(9); ++rep) {
    if (PH(9)) phase_ffn_in<0>(p, vb, G, smem);
    GSYNC();
  }

  if (PH(10)) phase_ffn_out(p, vb, G, smem);
}

extern "C" void kernel_launch(void* const* d_in, const int* in_sizes, int n_in, void* d_out, int out_size, void* d_ws, size_t ws_size,
                              hipStream_t stream) {
  static int grid_blocks = 0;
  if (!grid_blocks) {
    int dev = 0, cus = 0, per_cu = 0;
    (void)hipGetDevice(&dev);
    (void)hipDeviceGetAttribute(&cus, hipDeviceAttributeMultiprocessorCount, dev);
    (void)hipOccupancyMaxActiveBlocksPerMultiprocessor(&per_cu, hybrid_block_megakernel, 256, 0);
    if (per_cu > 1) per_cu = 1;
    grid_blocks = cus * per_cu;
  }
  Params p{};
  const float* const* in = (const float* const*)d_in;
  p.x = in[0]; p.c = in[1]; p.ctx = in[2]; p.c_ctx = in[3]; p.w_mod = in[4]; p.b_mod = in[5]; p.norm1 = in[6]; p.norm2 = in[7];
  p.w_in = in[8]; p.b_gate = in[9]; p.conv_w = in[10]; p.conv_b = in[11]; p.mlstm_norm = in[12]; p.q_norm = in[13]; p.k_norm = in[14];
  p.lam_vecs = in[15]; p.diff_norm = in[16]; p.w_a = in[17]; p.w_b = in[18]; p.w_out = in[19]; p.w_ffn_in = in[20]; p.w_ffn_out = in[21];
  p.out = (float*)d_out;
  unsigned char* ws = (unsigned char*)d_ws;
  size_t off = 0;
  auto take = [&](size_t bytes) { unsigned char* r = ws + off; off += (bytes + 255) & ~(size_t)255; return r; };
  p.bar = (unsigned*)take((size_t)XCD_BAR_WORDS * 4);
  (void)hipMemsetAsync(p.bar, 0, (size_t)XCD_BAR_WORDS * 4, stream);
  p.WinT = (bf16_t*)take((size_t)NWIN * 1024 * 2);
  p.WaT = (bf16_t*)take((size_t)1024 * 1024 * 2);
  p.WbT = (bf16_t*)take((size_t)1024 * 1024 * 2);
  p.WoT = (bf16_t*)take((size_t)1024 * 1024 * 2);
  p.WfiT = (bf16_t*)take((size_t)2 * FH * 1024 * 2);
  p.WfoT = (bf16_t*)take((size_t)1024 * FH * 2);
  p.mod = (float*)take((size_t)5 * 6144 * 4);
  p.rope = (float*)take((size_t)128 * 16 * 2 * 4);
  p.xn = (bf16_t*)take((size_t)NB * TB * DM * 2);
  const size_t r0 = off;
  p.P = (bf16_t*)take((size_t)TB * PLD * 2);
  p.gates = (float*)take((size_t)TB * 16 * 4);
  p.Qm = (bf16_t*)take((size_t)TB * 512 * 2);
  p.Km = (bf16_t*)take((size_t)TB * 512 * 2);
  p.KTm = (bf16_t*)take((size_t)512 * TB * 2);
  p.VTm = (bf16_t*)take((size_t)1024 * TB * 2);
  p.Qd = (bf16_t*)take((size_t)SEQ * 1024 * 2);
  p.Kd = (bf16_t*)take((size_t)TB * 1024 * 2);
  p.VTd = (bf16_t*)take((size_t)1024 * TB * 2);
  p.scal = (float*)take((size_t)8 * NSTEP * 256 * 4 * 4);
  p.stepsc = (float*)take((size_t)8 * NSTEP * 2 * 4);
  p.ST = (bf16_t*)take((size_t)8 * NSTEP * STROWS * 128 * 2);
  p.hA = (bf16_t*)take((size_t)SEQ * 1024 * 2);
  p.hB = (bf16_t*)take((size_t)SEQ * 1024 * 2);
  p.y = (bf16_t*)take((size_t)SEQ * 1024 * 2);
  p.xn2 = (bf16_t*)(ws + r0);
  p.hid = (bf16_t*)(ws + r0 + (size_t)NB * SEQ * DM * 2);
  if (off > ws_size || r0 + (size_t)NB * SEQ * DM * 2 + (size_t)NB * SEQ * FH * 2 > ws_size) fprintf(stderr, "workspace too small: need %zu have %zu\n", off, ws_size);
  void* args[] = {&p};
  hipError_t e = hipLaunchCooperativeKernel((void*)hybrid_block_megakernel, dim3(grid_blocks), dim3(256), args, 0, stream);
  if (e != hipSuccess) fprintf(stderr, "cooperative launch failed: %s (grid %d)\n", hipGetErrorString(e), grid_blocks);
}
```

```cpp
#include <hip/hip_runtime.h>
#include <hip/hip_cooperative_groups.h>
#include <cstdio>
#include <cstdint>
namespace cg = cooperative_groups;

#define DI __device__ __forceinline__
typedef unsigned short bf16_t;
typedef short bf16x8 __attribute__((ext_vector_type(8)));
typedef short bf16x4 __attribute__((ext_vector_type(4)));
typedef float f32x2 __attribute__((ext_vector_type(2)));
typedef float f32x4 __attribute__((ext_vector_type(4)));
typedef float f32x16 __attribute__((ext_vector_type(16)));
typedef unsigned u32x2 __attribute__((ext_vector_type(2)));
typedef unsigned u32x4 __attribute__((ext_vector_type(4)));
typedef __bf16 bfv2 __attribute__((ext_vector_type(2)));

constexpr int DM = 1024, NB = 4, SEQ = 8192, CTXL = 256, TB = SEQ + CTXL;
constexpr int PW = 8192;
constexpr int PLD = PW + 64;
constexpr int NWIN = 8448;
constexpr int FH = 2816;
constexpr int NSTEP = 33;
constexpr int STROWS = 288;
constexpr int SMEM_BYTES = 147456;

struct Params {
  const float *x, *c, *ctx, *c_ctx, *w_mod, *b_mod, *norm1, *norm2, *w_in, *b_gate, *conv_w, *conv_b, *mlstm_norm,
      *q_norm, *k_norm, *lam_vecs, *diff_norm, *w_a, *w_b, *w_out, *w_ffn_in, *w_ffn_out;
  float* out;
  bf16_t *WinT, *WaT, *WbT, *WoT, *WfiT, *WfoT;
  float *mod, *rope;
  bf16_t *xn, *P;
  float* gates;
  bf16_t *Qm, *Km, *KTm, *VTm, *Qd, *Kd, *VTd;
  float *scal, *stepsc;
  bf16_t *ST, *hA, *hB, *y, *xn2, *hid;
  unsigned* bar;
};

DI unsigned pk2(float a, float b) { f32x2 v = {a, b}; return __builtin_bit_cast(unsigned, __builtin_convertvector(v, bfv2)); }
DI bf16_t f2bf(float a) { return (bf16_t)(pk2(a, 0.f) & 0xffffu); }
DI float bf_lo(unsigned u) { return __uint_as_float(u << 16); }
DI float bf_hi(unsigned u) { return __uint_as_float(u & 0xffff0000u); }
DI float bf2f(bf16_t u) { return __uint_as_float(((unsigned)u) << 16); }
DI float siluf(float x) { return x * __builtin_amdgcn_rcpf(1.f + __expf(-x)); }
DI float sigmf(float x) { return __builtin_amdgcn_rcpf(1.f + __expf(-x)); }
DI f32x16 zero16() { f32x16 z; for (int i = 0; i < 16; ++i) z[i] = 0.f; return z; }
DI f32x4 zero4() { f32x4 z = {0.f, 0.f, 0.f, 0.f}; return z; }
#define MFMA32(a, b, c) __builtin_amdgcn_mfma_f32_32x32x16_bf16((a), (b), (c), 0, 0, 0)
#define MFMA16(a, b, c) __builtin_amdgcn_mfma_f32_16x16x32_bf16((a), (b), (c), 0, 0, 0)

DI bf16x8 pack8(const f32x16& x, int s) {
  u32x4 p;
  p[0] = pk2(x[8 * s + 0], x[8 * s + 1]); p[1] = pk2(x[8 * s + 2], x[8 * s + 3]);
  p[2] = pk2(x[8 * s + 4], x[8 * s + 5]); p[3] = pk2(x[8 * s + 6], x[8 * s + 7]);
  return __builtin_bit_cast(bf16x8, p);
}
DI bf16x8 cat4(u32x2 a, u32x2 b) { u32x4 p = {a[0], a[1], b[0], b[1]}; return __builtin_bit_cast(bf16x8, p); }

DI int srccol_win(int j) { if (j < 3072) return j; if (j < 8192) return j + 16; if (j < 8208) return 3072 + (j - 8192); return -1; }
DI int srccol_ffi(int r) { const int g = r >> 6, rr = r & 63; return rr < 32 ? g * 32 + rr : FH + g * 32 + (rr - 32); }

DI void wt_tile(const float* __restrict__ src, int ldsrc, int K, bf16_t* __restrict__ dst, int n0, int k0, int mode, bf16_t* sm) {
  const int t = threadIdx.x, nl = t & 63, kb = t >> 6;
  const int j = n0 + nl;
  const int sc = mode == 1 ? srccol_win(j) : (mode == 2 ? srccol_ffi(j) : j);
#pragma unroll 4
  for (int pss = 0; pss < 16; ++pss) {
    const int k = kb + 4 * pss;
    const float v = sc >= 0 ? src[(size_t)(k0 + k) * ldsrc + sc] : 0.f;
    sm[k * 66 + nl] = f2bf(v);
  }
  __syncthreads();
  const int n = t >> 2, ks = (t & 3) * 16;
  unsigned w[8];
#pragma unroll
  for (int i = 0; i < 8; ++i) w[i] = (unsigned)sm[(ks + 2 * i) * 66 + n] | ((unsigned)sm[(ks + 2 * i + 1) * 66 + n] << 16);
  u32x4* d = (u32x4*)(dst + (size_t)(n0 + n) * K + k0 + ks);
  d[0] = (u32x4){w[0], w[1], w[2], w[3]};
  d[1] = (u32x4){w[4], w[5], w[6], w[7]};
  __syncthreads();
}

DI void mod_task(const Params& p, int task, float* smf) {
  const int tid = threadIdx.x;
  for (int idx = tid; idx < 5 * 1024; idx += 256) {
    const int r = idx >> 10, k = idx & 1023;
    const float v = r < 4 ? p.c[r * 1024 + k] : p.c_ctx[k];
    smf[idx] = siluf(v);
  }
  __syncthreads();
  const int col = tid & 31, kg = tid >> 5, n = task * 32 + col;
  float acc[5] = {0.f, 0.f, 0.f, 0.f, 0.f};
  for (int k = kg * 128; k < kg * 128 + 128; ++k) {
    const float w = p.w_mod[(size_t)k * 6144 + n];
#pragma unroll
    for (int r = 0; r < 5; ++r) acc[r] += smf[r * 1024 + k] * w;
  }
  float* red = smf + 5120;
#pragma unroll
  for (int r = 0; r < 5; ++r) red[(kg * 32 + col) * 5 + r] = acc[r];
  __syncthreads();
  if (tid < 160) {
    const int r = tid >> 5, cc = tid & 31;
    float s = 0.f;
    for (int g = 0; g < 8; ++g) s += red[(g * 32 + cc) * 5 + r];
    p.mod[r * 6144 + task * 32 + cc] = s + p.b_mod[task * 32 + cc];
  }
  __syncthreads();
}

DI void phase0(const Params& p, int vb, int G, unsigned char* smem) {
  const int nWin = 132 * 16, nSq = 16 * 16, nFi = 88 * 16, nFo = 16 * 44;
  const int total = 193 + nWin + 3 * nSq + nFi + nFo;
  for (int t = vb; t < total; t += G) {
    if (t < 192) { mod_task(p, t, (float*)smem); continue; }
    if (t == 192) {
      for (int idx = threadIdx.x; idx < 128 * 16; idx += 256) {
        const int pos = idx >> 4, f = idx & 15;
        const float inv = exp2f(-(float)f * (13.287712379549449f / 16.0f));
        const float ang = (float)pos * inv;
        float rev = ang * 0.15915494309189535f; rev -= floorf(rev);
        p.rope[idx * 2 + 0] = __builtin_amdgcn_cosf(rev);
        p.rope[idx * 2 + 1] = __builtin_amdgcn_sinf(rev);
      }
      continue;
    }
    int u = t - 193;
    bf16_t* sm = (bf16_t*)smem;
    if (u < nWin) { wt_tile(p.w_in, 8208, 1024, p.WinT, (u >> 4) * 64, (u & 15) * 64, 1, sm); continue; }
    u -= nWin;
    if (u < nSq) { wt_tile(p.w_a, 1024, 1024, p.WaT, (u >> 4) * 64, (u & 15) * 64, 0, sm); continue; }
    u -= nSq;
    if (u < nSq) { wt_tile(p.w_b, 1024, 1024, p.WbT, (u >> 4) * 64, (u & 15) * 64, 0, sm); continue; }
    u -= nSq;
    if (u < nSq) { wt_tile(p.w_out, 1024, 1024, p.WoT, (u >> 4) * 64, (u & 15) * 64, 0, sm); continue; }
    u -= nSq;
    if (u < nFi) { wt_tile(p.w_ffn_in, 2 * FH, 1024, p.WfiT, (u >> 4) * 64, (u & 15) * 64, 2, sm); continue; }
    u -= nFi;
    wt_tile(p.w_ffn_out, 1024, FH, p.WfoT, (u / 44) * 64, (u % 44) * 64, 0, sm);
  }
}

DI void norm_row2(const float* __restrict__ srcA, const float* __restrict__ srcB, const float* __restrict__ gain, const float* __restrict__ shA, const float* __restrict__ scA,
                  const float* __restrict__ shB, const float* __restrict__ scB, bf16_t* __restrict__ dstA, bf16_t* __restrict__ dstB) {
  const int lane = threadIdx.x & 63;
  f32x4 va[4], vb2[4];
  float sa = 0.f, sb = 0.f;
#pragma unroll
  for (int i = 0; i < 4; ++i) { va[i] = *(const f32x4*)(srcA + (i * 64 + lane) * 4); vb2[i] = *(const f32x4*)(srcB + (i * 64 + lane) * 4); }
#pragma unroll
  for (int i = 0; i < 4; ++i) {
    sa += va[i][0] * va[i][0] + va[i][1] * va[i][1] + va[i][2] * va[i][2] + va[i][3] * va[i][3];
    sb += vb2[i][0] * vb2[i][0] + vb2[i][1] * vb2[i][1] + vb2[i][2] * vb2[i][2] + vb2[i][3] * vb2[i][3];
  }
#pragma unroll
  for (int o = 32; o >= 1; o >>= 1) { sa += __shfl_xor(sa, o); sb += __shfl_xor(sb, o); }
  const float ra = rsqrtf(sa * (1.0f / 1024.0f) + 1e-6f), rb = rsqrtf(sb * (1.0f / 1024.0f) + 1e-6f);
#pragma unroll
  for (int i = 0; i < 4; ++i) {
    const int k = (i * 64 + lane) * 4;
    const f32x4 g = *(const f32x4*)(gain + k);
    const f32x4 a1 = *(const f32x4*)(scA + k), a0 = *(const f32x4*)(shA + k), b1 = *(const f32x4*)(scB + k), b0 = *(const f32x4*)(shB + k);
    float oa[4], ob[4];
#pragma unroll
    for (int r = 0; r < 4; ++r) { oa[r] = va[i][r] * ra * g[r] * (1.f + a1[r]) + a0[r]; ob[r] = vb2[i][r] * rb * g[r] * (1.f + b1[r]) + b0[r]; }
    *(u32x2*)(dstA + k) = (u32x2){pk2(oa[0], oa[1]), pk2(oa[2], oa[3])};
    *(u32x2*)(dstB + k) = (u32x2){pk2(ob[0], ob[1]), pk2(ob[2], ob[3])};
  }
}

template <int NJ, bool SWAP = false>
DI void gemm_kloop(const bf16_t* __restrict__ A, int lda, const bf16_t* __restrict__ Bt, int ldb, int K, f32x16 (&acc)[4][NJ / 2], unsigned char* smem) {
  constexpr int BN = 32 * NJ, NBQ = BN / 32, NSL = 8 + NBQ, QPS = (NSL + 3) / 4, BUF = (256 + BN) * 72;
  int tid = threadIdx.x; asm volatile("" : "+v"(tid));
  const int lane = tid & 63, wid = tid >> 6, wm = wid >> 1, wn = wid & 1;
  const int l32 = lane & 31, hh = lane >> 5;
  const int lr = tid >> 3, lc = (tid & 7) * 8;
  const bf16_t* ap = A + (size_t)lr * lda + lc;
  const bf16_t* bp = Bt + (size_t)lr * ldb + lc;
  bf16_t* s0 = (bf16_t*)smem;
  u32x4 rg[NSL];
  const int nk = K >> 6;
#define SL_LOAD(Q, KT) do { if ((Q) < 8) rg[Q] = *(const u32x4*)(ap + (KT) * 64 + (size_t)(Q) * 32 * lda); \
                            else rg[Q] = *(const u32x4*)(bp + (KT) * 64 + (size_t)((Q) - 8) * 32 * ldb); } while (0)
#define SL_STORE(Q, BASE) do { if ((Q) < 8) *(u32x4*)((BASE) + (lr + 32 * (Q)) * 72 + lc) = rg[Q]; \
                               else *(u32x4*)((BASE) + 256 * 72 + (lr + 32 * ((Q) - 8)) * 72 + lc) = rg[Q]; } while (0)
#pragma unroll
  for (int q = 0; q < NSL; ++q) SL_LOAD(q, 0);
#pragma unroll
  for (int q = 0; q < NSL; ++q) SL_STORE(q, s0);
  {
    const int k1 = nk > 1 ? 1 : 0;
#pragma unroll
    for (int q = 0; q < NSL; ++q) SL_LOAD(q, k1);
  }
  __syncthreads();
#pragma unroll 1
  for (int kt = 0; kt < nk; ++kt) {
    const bf16_t* sa = s0 + (kt & 1) * BUF; const bf16_t* sb = sa + 256 * 72;
    bf16_t* so = s0 + ((kt & 1) ^ 1) * BUF;
    const int k2 = kt + 2 < nk ? kt + 2 : nk - 1;
    bf16x8 af[2][4], bfr[2][NJ / 2];
#pragma unroll
    for (int i = 0; i < 4; ++i) af[0][i] = *(const bf16x8*)(sa + (wm * 128 + i * 32 + l32) * 72 + hh * 8);
#pragma unroll
    for (int j = 0; j < NJ / 2; ++j) bfr[0][j] = *(const bf16x8*)(sb + (wn * 16 * NJ + j * 32 + l32) * 72 + hh * 8);
#pragma unroll
    for (int ks = 0; ks < 4; ++ks) {
      if (ks < 3) {
#pragma unroll
        for (int i = 0; i < 4; ++i) af[(ks + 1) & 1][i] = *(const bf16x8*)(sa + (wm * 128 + i * 32 + l32) * 72 + (ks + 1) * 16 + hh * 8);
#pragma unroll
        for (int j = 0; j < NJ / 2; ++j) bfr[(ks + 1) & 1][j] = *(const bf16x8*)(sb + (wn * 16 * NJ + j * 32 + l32) * 72 + (ks + 1) * 16 + hh * 8);
      }
#pragma unroll
      for (int q = ks * QPS; q < (ks + 1) * QPS && q < NSL; ++q) { SL_STORE(q, so); SL_LOAD(q, k2); }
#pragma unroll
      for (int i = 0; i < 4; ++i)
#pragma unroll
        for (int j = 0; j < NJ / 2; ++j) acc[i][j] = SWAP ? MFMA32(af[ks & 1][i], bfr[ks & 1][j], acc[i][j]) : MFMA32(bfr[ks & 1][j], af[ks & 1][i], acc[i][j]);
#pragma unroll
      for (int g = 0; g < 4 * (NJ / 2); ++g) {
        __builtin_amdgcn_sched_group_barrier(0x008, 1, 0);
        if (ks < 3 && g < 4 + NJ / 2) __builtin_amdgcn_sched_group_barrier(0x100, 1, 0);
        if (g < QPS) { __builtin_amdgcn_sched_group_barrier(0x200, 1, 0); __builtin_amdgcn_sched_group_barrier(0x020, 1, 0); }
      }
      __builtin_amdgcn_sched_barrier(0);
    }
    __syncthreads();
  }
#undef SL_LOAD
#undef SL_STORE
}
template <int NJ2>
DI void acc_zero(f32x16 (&acc)[4][NJ2]) {
#pragma unroll
  for (int i = 0; i < 4; ++i)
#pragma unroll
    for (int j = 0; j < NJ2; ++j) acc[i][j] = zero16();
}
#define EPI_COORDS(NJ) int tid = threadIdx.x; asm volatile("" : "+v"(tid)); const int lane = tid & 63, wid = tid >> 6, wm = wid >> 1, wn = wid & 1, l32 = lane & 31, hh = lane >> 5
DI void tile_map(int t, int NTn, int GM, int& mt, int& nt) { const int per = GM * NTn, g = t / per, r = t % per; mt = g * GM + r % GM; nt = r / GM; }

DI void phase_inproj(const Params& p, int b, int vb, int G, unsigned char* smem) {
  EPI_COORDS(4);
  const int MT = 33, NTn = 66;
  const bf16_t* A = p.xn + (size_t)b * TB * DM;
  for (int t = vb; t < MT * NTn; t += G) {
    int mt, nt; tile_map(t, NTn, 3, mt, nt);
    const int reg = nt >> 3;
    if (nt == 65 || (mt == 32 && (reg == 2 || reg == 3 || reg == 6 || reg == 7))) continue;
    if (nt < 65 && (reg == 1 || reg == 5)) {
      f32x16 acc[4][2]; acc_zero(acc);
      gemm_kloop<4, true>(A + (size_t)mt * 256 * DM, DM, p.WinT + (size_t)nt * 128 * DM, DM, DM, acc, smem);
      bf16_t* dstT = reg == 1 ? p.VTm : p.VTd;
      bf16_t* sT2 = (bf16_t*)smem;
#pragma unroll
      for (int i = 0; i < 4; ++i)
#pragma unroll
        for (int j = 0; j < 2; ++j)
#pragma unroll
          for (int r4 = 0; r4 < 4; ++r4)
            *(u32x2*)(sT2 + (wn * 64 + j * 32 + l32) * 264 + wm * 128 + i * 32 + 8 * r4 + 4 * hh) =
                (u32x2){pk2(acc[i][j][4 * r4], acc[i][j][4 * r4 + 1]), pk2(acc[i][j][4 * r4 + 2], acc[i][j][4 * r4 + 3])};
      __syncthreads();
      {
        const int rrow = tid >> 5, ch = tid & 31;
        bf16_t* dbase = dstT + (size_t)((nt & 7) * 128) * TB + mt * 256 + ch * 8;
#pragma unroll 2
        for (int q = 0; q < 16; ++q) {
          const int row = rrow + 8 * q;
          *(u32x4*)(dbase + (size_t)row * TB) = *(const u32x4*)(sT2 + row * 264 + ch * 8);
        }
      }
      __syncthreads();
      continue;
    }
    f32x16 acc[4][2]; acc_zero(acc);
    gemm_kloop<4>(A + (size_t)mt * 256 * DM, DM, p.WinT + (size_t)nt * 128 * DM, DM, DM, acc, smem);
    if (reg == 3 || reg == 4) {
      const bool isq = reg == 3;
      if (isq && mt == 32) continue;
      const float* gn = isq ? p.q_norm : p.k_norm;
      bf16_t* dst = isq ? p.Qd : p.Kd;
      const int c0 = (nt & 7) * 128 + wn * 64;
      const float osc = isq ? 0.125f * 1.4426950408889634f : 1.0f;
#pragma unroll
      for (int i = 0; i < 4; ++i) {
        const int tau = mt * 256 + wm * 128 + i * 32 + l32;
        float ss = 0.f;
#pragma unroll
        for (int j = 0; j < 2; ++j)
#pragma unroll
          for (int r = 0; r < 16; ++r) ss += acc[i][j][r] * acc[i][j][r];
        ss += __shfl_xor(ss, 32);
        const float rstd = rsqrtf(ss * (1.0f / 64.0f) + 1e-6f);
#pragma unroll
        for (int j = 0; j < 2; ++j) {
          float v[16];
#pragma unroll
          for (int r4 = 0; r4 < 4; ++r4) {
            const f32x4 g4 = *(const f32x4*)(gn + j * 32 + 8 * r4 + 4 * hh);
#pragma unroll
            for (int r = 0; r < 4; ++r) v[4 * r4 + r] = acc[i][j][4 * r4 + r] * rstd * g4[r];
          }
          if (mt < 32) {
            const int pos = j == 0 ? (tau >> 6) : (tau & 63);
            const float* rp = p.rope + pos * 32;
#pragma unroll
            for (int r4 = 0; r4 < 2; ++r4) {
              const f32x4 cs0 = *(const f32x4*)(rp + 2 * (8 * r4 + 4 * hh)), cs1 = *(const f32x4*)(rp + 2 * (8 * r4 + 4 * hh) + 4);
              const float cs[8] = {cs0[0], cs0[1], cs0[2], cs0[3], cs1[0], cs1[1], cs1[2], cs1[3]};
#pragma unroll
              for (int r = 0; r < 4; ++r) {
                const float x1 = v[4 * r4 + r], x2 = v[4 * (r4 + 2) + r], c = cs[2 * r], sn = cs[2 * r + 1];
                v[4 * r4 + r] = x1 * c - x2 * sn; v[4 * (r4 + 2) + r] = x2 * c + x1 * sn;
              }
            }
          }
#pragma unroll
          for (int r4 = 0; r4 < 4; ++r4)
            *(u32x2*)((bf16_t*)smem + (wm * 128 + i * 32 + l32) * 136 + wn * 64 + j * 32 + 8 * r4 + 4 * hh) = (u32x2){pk2(v[4 * r4] * osc, v[4 * r4 + 1] * osc), pk2(v[4 * r4 + 2] * osc, v[4 * r4 + 3] * osc)};
        }
      }
      __syncthreads();
      {
        const int rrow = tid >> 4, ch = tid & 15;
        bf16_t* dbase = dst + (size_t)(mt * 256) * 1024 + (nt & 7) * 128 + ch * 8;
#pragma unroll 2
        for (int q = 0; q < 16; ++q) {
          const int row = rrow + 16 * q;
          *(u32x4*)(dbase + (size_t)row * 1024) = *(const u32x4*)((const bf16_t*)smem + row * 136 + ch * 8);
        }
      }
      __syncthreads();
      continue;
    }
    bf16_t* sT = (bf16_t*)smem;
    if (nt < 64) {
#pragma unroll
      for (int i = 0; i < 4; ++i)
#pragma unroll
        for (int j = 0; j < 2; ++j)
#pragma unroll
          for (int r4 = 0; r4 < 4; ++r4)
            *(u32x2*)(sT + (wm * 128 + i * 32 + l32) * 136 + wn * 64 + j * 32 + 8 * r4 + 4 * hh) =
                (u32x2){pk2(acc[i][j][4 * r4], acc[i][j][4 * r4 + 1]), pk2(acc[i][j][4 * r4 + 2], acc[i][j][4 * r4 + 3])};
      __syncthreads();
      {
        const int rrow = tid >> 4, ch = tid & 15;
        bf16_t* dbase = p.P + (size_t)(mt * 256) * PLD + nt * 128 + ch * 8;
#pragma unroll 2
        for (int q = 0; q < 16; ++q) {
          const int row = rrow + 16 * q;
          *(u32x4*)(dbase + (size_t)row * PLD) = *(const u32x4*)(sT + row * 136 + ch * 8);
        }
      }
      if (reg != 0) { __syncthreads(); continue; }
    }
    if (reg == 0) {
      const int cg = tid & 31, tg = tid >> 5, c0 = nt * 128 + cg * 4, t0 = tg * 32;
      float w[5][4], bias[4];
#pragma unroll
      for (int j = 0; j < 5; ++j) {
        const f32x4 a0 = *(const f32x4*)(p.conv_w + j * 1024 + c0);
#pragma unroll
        for (int e = 0; e < 4; ++e) w[j][e] = a0[e];
      }
      {
        const f32x4 a0 = *(const f32x4*)(p.conv_b + c0);
#pragma unroll
        for (int e = 0; e < 4; ++e) bias[e] = a0[e];
      }
      const float osc = nt < 4 ? 0.08838834764831845f : 1.0f;
      float win[5][4];
#pragma unroll
      for (int j = 0; j < 4; ++j) {
        int rr = t0 - 2 + j; rr = rr < 0 ? 0 : rr;
        const u32x2 v = *(const u32x2*)(sT + rr * 136 + cg * 4);
        win[j + 1][0] = bf_lo(v[0]); win[j + 1][1] = bf_hi(v[0]); win[j + 1][2] = bf_lo(v[1]); win[j + 1][3] = bf_hi(v[1]);
      }
      unsigned outp[4][4];
#pragma unroll
      for (int tt = 0; tt < 32; ++tt) {
#pragma unroll
        for (int j = 0; j < 4; ++j)
#pragma unroll
          for (int e = 0; e < 4; ++e) win[j][e] = win[j + 1][e];
        int rr = t0 + tt + 2; rr = rr > 255 ? 255 : rr;
        const u32x2 v = *(const u32x2*)(sT + rr * 136 + cg * 4);
        win[4][0] = bf_lo(v[0]); win[4][1] = bf_hi(v[0]); win[4][2] = bf_lo(v[1]); win[4][3] = bf_hi(v[1]);
        float o[4];
#pragma unroll
        for (int e = 0; e < 4; ++e) {
          float a = bias[e];
#pragma unroll
          for (int j = 0; j < 5; ++j) a += win[j][e] * w[j][e];
          o[e] = siluf(a) * osc;
        }
        const int tau = mt * 256 + t0 + tt;
        const u32x2 pk = {pk2(o[0], o[1]), pk2(o[2], o[3])};
        if (nt < 4) *(u32x2*)(p.Qm + (size_t)tau * 512 + c0) = pk;
        else {
          *(u32x2*)(p.Km + (size_t)tau * 512 + (c0 - 512)) = pk;
#pragma unroll
          for (int e = 0; e < 4; ++e) {
            const unsigned hv = (e & 1) ? (pk[e >> 1] >> 16) : (pk[e >> 1] & 0xffffu);
            if (tt & 1) outp[e][(tt >> 1) & 3] |= hv << 16; else outp[e][(tt >> 1) & 3] = hv;
          }
          if ((tt & 7) == 7) {
#pragma unroll
            for (int e = 0; e < 4; ++e)
              *(u32x4*)(p.KTm + (size_t)(c0 - 512 + e) * TB + mt * 256 + t0 + (tt & 24)) = (u32x4){outp[e][0], outp[e][1], outp[e][2], outp[e][3]};
          }
        }
      }
      __syncthreads();
    }
    if (nt == 64 && wn == 0) {
#pragma unroll
      for (int i = 0; i < 4; ++i) {
        const int m = mt * 256 + wm * 128 + i * 32 + l32;
#pragma unroll
        for (int r4 = 0; r4 < 2; ++r4) {
          const int gc = 8 * r4 + 4 * hh, type = gc >> 2;
          f32x4 o;
#pragma unroll
          for (int r = 0; r < 4; ++r) {
            float g = acc[i][0][4 * r4 + r] + p.b_gate[gc + r];
            if (type & 1) g = fminf(g, 0.f) - __logf(1.f + __expf(-fabsf(g)));
            o[r] = g;
          }
          *(f32x4*)(p.gates + (size_t)m * 16 + gc) = o;
        }
      }
    }
  }
}

DI void load16(const bf16_t* src, float (&v)[16]) {
  const u32x4 a = *(const u32x4*)src, b2 = *(const u32x4*)(src + 8);
#pragma unroll
  for (int i = 0; i < 4; ++i) { v[2 * i] = bf_lo(a[i]); v[2 * i + 1] = bf_hi(a[i]); v[8 + 2 * i] = bf_lo(b2[i]); v[8 + 2 * i + 1] = bf_hi(b2[i]); }
}
DI void store16(bf16_t* dst, const float (&v)[16]) {
  u32x4 a, b2;
#pragma unroll
  for (int i = 0; i < 4; ++i) { a[i] = pk2(v[2 * i], v[2 * i + 1]); b2[i] = pk2(v[8 + 2 * i], v[8 + 2 * i + 1]); }
  *(u32x4*)dst = a; *(u32x4*)(dst + 8) = b2;
}
DI void tile_transpose_store(bf16_t* sm, const float (&v)[16], bf16_t* dstT, size_t ld, int col0, int tok0) {
  int tid = threadIdx.x; asm volatile("" : "+v"(tid));
  const int r = tid >> 2, seg = tid & 3;
#pragma unroll
  for (int i = 0; i < 16; ++i) sm[r * 66 + seg * 16 + i] = f2bf(v[i]);
  __syncthreads();
  const int col = tid >> 2, ts = (tid & 3) * 16;
  unsigned w[8];
#pragma unroll
  for (int i = 0; i < 8; ++i) w[i] = (unsigned)sm[(ts + 2 * i) * 66 + col] | ((unsigned)sm[(ts + 2 * i + 1) * 66 + col] << 16);
  u32x4* d = (u32x4*)(dstT + (size_t)(col0 + col) * ld + tok0 + ts);
  d[0] = (u32x4){w[0], w[1], w[2], w[3]};
  d[1] = (u32x4){w[4], w[5], w[6], w[7]};
  __syncthreads();
}

DI void scan_step(const Params& p, int chain, int i, float m, bool finalize, float& BL_out, float& pmax_out) {
  int tidl = threadIdx.x; asm volatile("" : "+v"(tidl));
  const int lane = tidl & 63, h = chain >> 1, dir = chain & 1;
  const int gi = (dir ? 8 : 0) + h, gf = (dir ? 12 : 4) + h;
  const int tau0 = i == 0 ? SEQ : (dir ? (32 - i) * 256 : (i - 1) * 256);
  float ig[4], B[4], a[4], pm[4];
  float run = 0.f;
#pragma unroll
  for (int r = 0; r < 4; ++r) {
    const int j = 4 * lane + r, pos = dir ? 255 - j : j;
    const float* g = p.gates + (size_t)(tau0 + pos) * 16;
    ig[r] = g[gi]; run += g[gf]; B[r] = run;
  }
  float inc = run;
#pragma unroll
  for (int o = 1; o < 64; o <<= 1) { const float t = __shfl_up(inc, o); if (lane >= o) inc += t; }
  const float excl = inc - run;
  const float BL = __shfl(inc, 63);
  float rmax = -3.0e38f;
#pragma unroll
  for (int r = 0; r < 4; ++r) { B[r] += excl; a[r] = ig[r] - B[r]; rmax = fmaxf(rmax, a[r]); pm[r] = rmax; }
  float incm = rmax;
#pragma unroll
  for (int o = 1; o < 64; o <<= 1) { const float t = __shfl_up(incm, o); if (lane >= o) incm = fmaxf(incm, t); }
  float exm = __shfl_up(incm, 1); if (lane == 0) exm = -3.0e38f;
  const float pmax_all = __shfl(incm, 63);
  BL_out = BL; pmax_out = pmax_all;
  if (finalize) {
    const float g255 = fmaxf(m, pmax_all);
    float* sc = p.scal + (size_t)(chain * NSTEP + i) * 1024;
#pragma unroll
    for (int r = 0; r < 4; ++r) {
      const int j = 4 * lane + r, pos = dir ? 255 - j : j;
      const float gj = fmaxf(m, fmaxf(exm, pm[r]));
      f32x4 o = {a[r], gj, B[r] + gj, __expf(a[r] - g255)};
      *(f32x4*)(sc + pos * 4) = o;
    }
    if (lane == 0) { p.stepsc[(chain * NSTEP + i) * 2] = m; p.stepsc[(chain * NSTEP + i) * 2 + 1] = __expf(m - g255); }
  }
}
DI void scalar_scan_block(const Params& p, int chain, float* sm) {
  const int lane = threadIdx.x & 63, wid = threadIdx.x >> 6;
  __syncthreads();
  for (int i = wid; i < NSTEP; i += 4) {
    float BL, pm; scan_step(p, chain, i, 0.f, false, BL, pm);
    if (lane == 0) { sm[i] = BL; sm[64 + i] = pm; }
  }
  __syncthreads();
  float m = 0.f;
  for (int i = 0; i < NSTEP; ++i) {
    if ((i & 3) == wid) { float BL, pm; scan_step(p, chain, i, m, true, BL, pm); }
    m = sm[i] + fmaxf(m, sm[64 + i]);
  }
  __syncthreads();
}

DI void phase_prep(const Params& p, int b, int vb, int G, unsigned char* smem) {
  bf16_t* sm = (bf16_t*)smem;
  int tid = threadIdx.x; asm volatile("" : "+v"(tid));
  const int r = tid >> 2, seg = tid & 3;
  const int nA = 33, nB = 0, nC = 0, nD = 0, nE = 0;
  const int total = 8 + nA;
  for (int t = vb; t < total; t += G) {
    if (t < 8) { scalar_scan_block(p, t, (float*)smem); continue; }
    int u = t - 8;
    if (u < nA) {
      const int mtile = u, brow = tid >> 6, c0 = (tid & 63) * 16;
      const int tau = mtile * 256 + (brow < 2 ? brow : 252 + brow);
      const int lo = mtile < 32 ? 0 : SEQ, hi = mtile < 32 ? SEQ : TB;
      float acc[16];
#pragma unroll
      for (int i = 0; i < 16; ++i) acc[i] = p.conv_b[c0 + i];
#pragma unroll
      for (int j = 0; j < 5; ++j) {
        const int t2 = tau + j - 2;
        if (t2 >= lo && t2 < hi) {
          float xv[16]; load16(p.P + (size_t)t2 * PLD + c0, xv);
#pragma unroll
          for (int i = 0; i < 16; ++i) acc[i] += xv[i] * p.conv_w[j * 1024 + c0 + i];
        }
      }
      if (c0 < 512) {
#pragma unroll
        for (int i = 0; i < 16; ++i) acc[i] = siluf(acc[i]) * 0.08838834764831845f;
        store16(p.Qm + (size_t)tau * 512 + c0, acc);
      } else {
#pragma unroll
        for (int i = 0; i < 16; ++i) acc[i] = siluf(acc[i]);
        store16(p.Km + (size_t)tau * 512 + (c0 - 512), acc);
#pragma unroll
        for (int i = 0; i < 16; ++i) p.KTm[(size_t)(c0 - 512 + i) * TB + tau] = f2bf(acc[i]);
      }
      continue;
    }
    u -= nA;
    if (u < nB) {
      const int ct = u & 15, tt = u >> 4, tau = tt * 64 + r;
      float xv[16]; load16(p.P + (size_t)tau * PLD + 1024 + ct * 64 + seg * 16, xv);
      tile_transpose_store(sm, xv, p.VTm, TB, ct * 64, tt * 64);
      continue;
    }
    u -= nB;
    if (u < nC + nD) {
      const bool isq = u < nC;
      if (!isq) u -= nC;
      const int ct = u & 15, tt = u >> 4, tau = tt * 64 + r;
      float xv[16]; load16(p.P + (size_t)tau * PLD + (isq ? 3072 : 4096) + ct * 64 + seg * 16, xv);
      float ss = 0.f;
#pragma unroll
      for (int i = 0; i < 16; ++i) ss += xv[i] * xv[i];
      ss += __shfl_xor(ss, 1); ss += __shfl_xor(ss, 2);
      const float rstd = rsqrtf(ss * (1.0f / 64.0f) + 1e-6f);
      const float* gn = (isq ? p.q_norm : p.k_norm) + seg * 16;
#pragma unroll
      for (int i = 0; i < 16; ++i) xv[i] = xv[i] * rstd * gn[i];
      if (tt < 128) {
        const int pos = seg < 2 ? (tau >> 6) : (tau & 63);
        const float* rp = p.rope + pos * 32;
#pragma unroll
        for (int i = 0; i < 16; ++i) {
          const float other = __shfl_xor(xv[i], 1);
          const float cs = rp[2 * i], sn = rp[2 * i + 1];
          xv[i] = (seg & 1) ? xv[i] * cs + other * sn : xv[i] * cs - other * sn;
        }
      }
      if (isq) {
#pragma unroll
        for (int i = 0; i < 16; ++i) xv[i] *= 0.125f * 1.4426950408889634f;
        store16(p.Qd + (size_t)tau * 1024 + ct * 64 + seg * 16, xv);
      } else {
        store16(p.Kd + (size_t)tau * 1024 + ct * 64 + seg * 16, xv);
      }
      continue;
    }
    u -= nC + nD;
    {
      const int ct = u & 15, tt = u >> 4, tau = tt * 64 + r;
      float xv[16]; load16(p.P + (size_t)tau * PLD + 5120 + ct * 64 + seg * 16, xv);
      tile_transpose_store(sm, xv, p.VTd, TB, ct * 64, tt * 64);
    }
  }
}

DI void phase_mlstm_u(const Params& p, int vb, int G, unsigned char* smem) {
  bf16_t* sV = (bf16_t*)smem;
  bf16_t* sKT = (bf16_t*)(smem + 36864);
  float* sw = (float*)(smem + 36864 + 18432);
  int tid = threadIdx.x; asm volatile("" : "+v"(tid));
  const int lane = tid & 63, wid = tid >> 6, l32 = lane & 31, hh = lane >> 5;
  for (int t = vb; t < 8 * NSTEP; t += G) {
    const int chain = t / NSTEP, i = t % NSTEP, h = chain >> 1, dir = chain & 1;
    const int tau0 = i == 0 ? SEQ : (dir ? (32 - i) * 256 : (i - 1) * 256);
    bf16_t* dstS = p.ST + (size_t)t * (STROWS * 128);
    __syncthreads();
    sw[tid] = p.scal[((size_t)t * 256 + tid) * 4 + 3];
    f32x16 acc[4][2];
#pragma unroll
    for (int a = 0; a < 4; ++a) { acc[a][0] = zero16(); acc[a][1] = zero16(); }
    float nsum = 0.f;
    for (int st = 0; st < 4; ++st) {
      __syncthreads();
      {
        const int seg = tid & 7;
#pragma unroll
        for (int q = 0; q < 8; ++q) {
          const int e = (tid >> 3) + 32 * q;
          *(u32x4*)(sV + e * 72 + seg * 8) = *(const u32x4*)(p.VTm + (size_t)(h * 256 + e) * TB + tau0 + st * 64 + seg * 8);
        }
#pragma unroll
        for (int q = 0; q < 4; ++q) {
          const int d = (tid >> 3) + 32 * q;
          const u32x4 kv = *(const u32x4*)(p.KTm + (size_t)(h * 128 + d) * TB + tau0 + st * 64 + seg * 8);
          const float* wp = sw + st * 64 + seg * 8;
          u32x4 o;
#pragma unroll
          for (int z = 0; z < 4; ++z) o[z] = pk2(bf_lo(kv[z]) * wp[2 * z], bf_hi(kv[z]) * wp[2 * z + 1]);
          *(u32x4*)(sKT + d * 72 + seg * 8) = o;
        }
      }
      __syncthreads();
#pragma unroll
      for (int ks = 0; ks < 4; ++ks) {
        bf16x8 kf[4], vf[2];
#pragma unroll
        for (int a = 0; a < 4; ++a) kf[a] = *(const bf16x8*)(sKT + (a * 32 + l32) * 72 + ks * 16 + hh * 8);
#pragma unroll
        for (int e2 = 0; e2 < 2; ++e2) vf[e2] = *(const bf16x8*)(sV + ((wid + 4 * e2) * 32 + l32) * 72 + ks * 16 + hh * 8);
#pragma unroll
        for (int a = 0; a < 4; ++a)
#pragma unroll
          for (int e2 = 0; e2 < 2; ++e2) acc[a][e2] = MFMA32(kf[a], vf[e2], acc[a][e2]);
      }
      if (tid < 128) {
#pragma unroll 8
        for (int s = 0; s < 64; ++s) nsum += bf2f(sKT[tid * 72 + s]);
      }
    }
#pragma unroll
    for (int a = 0; a < 4; ++a)
#pragma unroll
      for (int e2 = 0; e2 < 2; ++e2) {
        const int e = (wid + 4 * e2) * 32 + l32;
#pragma unroll
        for (int i4 = 0; i4 < 4; ++i4) {
          const int d0 = a * 32 + 8 * i4 + 4 * hh;
          const f32x16& v = acc[a][e2];
          *(u32x2*)(dstS + (size_t)e * 128 + d0) = (u32x2){pk2(v[4 * i4], v[4 * i4 + 1]), pk2(v[4 * i4 + 2], v[4 * i4 + 3])};
        }
      }
    if (tid < 128) dstS[256 * 128 + tid] = f2bf(nsum);
    for (int idx = tid; idx < 31 * 128 / 2; idx += 256) ((unsigned*)(dstS + 257 * 128))[idx] = 0u;
  }
}

DI void phase_mlstm_scan(const Params& p, int vb, int G) {
  const int pairs = STROWS * 128 / 2;
  const int ntask = 8 * pairs / 256;
  for (int t = vb; t < ntask; t += G) {
    int tidl = threadIdx.x; asm volatile("" : "+v"(tidl));
    const int gidx = t * 256 + tidl;
    const int chain = gidx / pairs, e2 = gidx % pairs;
    unsigned* base = (unsigned*)(p.ST + (size_t)chain * NSTEP * (STROWS * 128)) + e2;
    unsigned u[NSTEP];
#pragma unroll
    for (int i = 0; i < NSTEP; ++i) u[i] = base[(size_t)i * pairs];
    float s0 = 0.f, s1 = 0.f;
#pragma unroll
    for (int i = 0; i < NSTEP; ++i) {
      const float dec = p.stepsc[(chain * NSTEP + i) * 2 + 1];
      base[(size_t)i * pairs] = pk2(s0, s1);
      s0 = dec * s0 + bf_lo(u[i]); s1 = dec * s1 + bf_hi(u[i]);
    }
  }
}

DI void mlstm_out_task(const Params& p, int task, unsigned char* smem) {
  const int half = task & 1, c = (task >> 1) & 31, h = task >> 6;
  bf16_t* sK = (bf16_t*)smem;
  bf16_t* sV = (bf16_t*)(smem + 17408);
  float* sA = (float*)(smem + 17408 + 36864);
  int tid = threadIdx.x; asm volatile("" : "+v"(tid));
  const int lane = tid & 63, wid = tid >> 6, l32 = lane & 31, hh = lane >> 5;
  const int qi = half * 4 + wid, pq = qi * 32 + l32, tq = c * 256 + pq;
  bf16x8 qf[8];
#pragma unroll
  for (int ks = 0; ks < 8; ++ks) qf[ks] = *(const bf16x8*)(p.Qm + (size_t)tq * 512 + h * 128 + ks * 16 + hh * 8);
  bf16_t* hrow = p.hA + (size_t)tq * 1024 + h * 256;
  f32x16 num[8];
#pragma unroll 1
  for (int dir = 0; dir < 2; ++dir) {
    const int chain = h * 2 + dir, i = dir ? 32 - c : c + 1, sbase = chain * NSTEP + i;
    const float* sc = p.scal + (size_t)sbase * 1024;
    const float m_prev = p.stepsc[sbase * 2];
    const float g_q = sc[pq * 4 + 1], mj_q = sc[pq * 4 + 2];
    __syncthreads();
    sA[tid] = sc[tid * 4];
    f32x16 dent = zero16();
#pragma unroll
    for (int eb = 0; eb < 8; ++eb) num[eb] = zero16();
    float rs = 0.f;
    const int st_lo = dir == 0 ? 0 : half * 2, st_hi = dir == 0 ? half * 2 + 1 : 3;
    u32x4 rk[4], rv[8];
    {
      const int seg = tid & 15, sg = tid & 7;
#pragma unroll
      for (int q = 0; q < 4; ++q) rk[q] = *(const u32x4*)(p.Km + (size_t)(c * 256 + st_lo * 64 + (tid >> 4) + 16 * q) * 512 + h * 128 + seg * 8);
#pragma unroll
      for (int q = 0; q < 8; ++q) rv[q] = *(const u32x4*)(p.VTm + (size_t)(h * 256 + (tid >> 3) + 32 * q) * TB + c * 256 + st_lo * 64 + sg * 8);
    }
#pragma unroll 1
    for (int st = st_lo; st <= st_hi; ++st) {
      __syncthreads();
      {
        const int seg = tid & 15, sg = tid & 7;
#pragma unroll
        for (int q = 0; q < 4; ++q) *(u32x4*)(sK + ((tid >> 4) + 16 * q) * 136 + seg * 8) = rk[q];
#pragma unroll
        for (int q = 0; q < 8; ++q) *(u32x4*)(sV + ((tid >> 3) + 32 * q) * 72 + sg * 8) = rv[q];
      }
      __syncthreads();
      {
        const int sn = st < st_hi ? st + 1 : st;
        const int seg = tid & 15, sg = tid & 7;
#pragma unroll
        for (int q = 0; q < 4; ++q) rk[q] = *(const u32x4*)(p.Km + (size_t)(c * 256 + sn * 64 + (tid >> 4) + 16 * q) * 512 + h * 128 + seg * 8);
#pragma unroll
        for (int q = 0; q < 8; ++q) rv[q] = *(const u32x4*)(p.VTm + (size_t)(h * 256 + (tid >> 3) + 32 * q) * TB + c * 256 + sn * 64 + sg * 8);
      }
#pragma unroll 1
      for (int sub = 0; sub < 2; ++sub) {
        const int ki = st * 2 + sub;
        const bool need = dir == 0 ? ki <= qi : ki >= qi;
        if (!need) continue;
        f32x16 S = zero16();
#pragma unroll
        for (int ks = 0; ks < 8; ++ks) {
          const bf16x8 a = *(const bf16x8*)(sK + (sub * 32 + l32) * 136 + ks * 16 + hh * 8);
          S = MFMA32(a, qf[ks], S);
        }
#pragma unroll
        for (int i4 = 0; i4 < 4; ++i4) {
          const f32x4 av = *(const f32x4*)(sA + ki * 32 + 8 * i4 + 4 * hh);
#pragma unroll
          for (int r = 0; r < 4; ++r) {
            const int sp = ki * 32 + 8 * i4 + 4 * hh + r;
            const bool ok = dir == 0 ? sp <= pq : sp >= pq;
            const float dm = ok ? __expf(av[r] - g_q) : 0.f;
            const float v = S[4 * i4 + r] * dm;
            S[4 * i4 + r] = v; rs += v;
          }
        }
        const bf16x8 pf0 = pack8(S, 0), pf1 = pack8(S, 1);
#pragma unroll
        for (int eb = 0; eb < 8; ++eb) {
          const bf16_t* vr = sV + (eb * 32 + l32) * 72 + sub * 32 + 4 * hh;
          const bf16x8 v0 = cat4(*(const u32x2*)(vr), *(const u32x2*)(vr + 8));
          const bf16x8 v1 = cat4(*(const u32x2*)(vr + 16), *(const u32x2*)(vr + 24));
          num[eb] = MFMA32(v0, pf0, num[eb]);
          num[eb] = MFMA32(v1, pf1, num[eb]);
        }
      }
    }
    const float inter = __expf(m_prev - g_q);
    const bf16_t* Cst = p.ST + (size_t)sbase * (STROWS * 128);
    {
      bf16x8 cf[2][8];
#pragma unroll
      for (int ks = 0; ks < 8; ++ks) cf[0][ks] = *(const bf16x8*)(Cst + (size_t)l32 * 128 + ks * 16 + hh * 8);
#pragma unroll
      for (int eb = 0; eb < 9; ++eb) {
        if (eb < 8) {
#pragma unroll
          for (int ks = 0; ks < 8; ++ks) cf[(eb + 1) & 1][ks] = *(const bf16x8*)(Cst + (size_t)((eb + 1) * 32 + l32) * 128 + ks * 16 + hh * 8);
        }
        f32x16 tmp = zero16();
#pragma unroll
        for (int ks = 0; ks < 8; ++ks) tmp = MFMA32(cf[eb & 1][ks], qf[ks], tmp);
        if (eb < 8) {
#pragma unroll
          for (int r = 0; r < 16; ++r) num[eb][r] += inter * tmp[r];
        } else {
          dent = tmp;
        }
        __builtin_amdgcn_sched_barrier(0);
      }
    }
    rs += __shfl_xor(rs, 32);
    const float dn = inter * __shfl(dent[0], l32);
    const float den = rs + dn;
    const float inv = 1.0f / fmaxf(fabsf(den), __expf(-mj_q));
    if (dir == 0) {
#pragma unroll
      for (int eb = 0; eb < 8; ++eb)
#pragma unroll
        for (int i4 = 0; i4 < 4; ++i4) {
          const f32x16& v = num[eb];
          *(u32x2*)(hrow + eb * 32 + 8 * i4 + 4 * hh) = (u32x2){pk2(v[4 * i4] * inv, v[4 * i4 + 1] * inv), pk2(v[4 * i4 + 2] * inv, v[4 * i4 + 3] * inv)};
        }
    } else {
#pragma unroll
      for (int eb = 0; eb < 8; ++eb)
#pragma unroll
        for (int i4 = 0; i4 < 4; ++i4) {
          const u32x2 st2 = *(const u32x2*)(hrow + eb * 32 + 8 * i4 + 4 * hh);
          num[eb][4 * i4 + 0] = bf_lo(st2[0]) + num[eb][4 * i4 + 0] * inv;
          num[eb][4 * i4 + 1] = bf_hi(st2[0]) + num[eb][4 * i4 + 1] * inv;
          num[eb][4 * i4 + 2] = bf_lo(st2[1]) + num[eb][4 * i4 + 2] * inv;
          num[eb][4 * i4 + 3] = bf_hi(st2[1]) + num[eb][4 * i4 + 3] * inv;
          if (i4 == 3) asm volatile("" ::: "memory");
        }
    }
  }
  float ss = 0.f;
#pragma unroll
  for (int eb = 0; eb < 8; ++eb)
#pragma unroll
    for (int r = 0; r < 16; ++r) ss += num[eb][r] * num[eb][r];
  ss += __shfl_xor(ss, 32);
  const float rstd = rsqrtf(ss * (1.0f / 256.0f) + 1e-6f);
  const bf16_t* morow = p.P + (size_t)tq * PLD + 2048 + h * 256;
#pragma unroll
  for (int eb = 0; eb < 8; ++eb)
#pragma unroll
    for (int i4 = 0; i4 < 4; ++i4) {
      const int e0 = eb * 32 + 8 * i4 + 4 * hh;
      const f32x4 gn = *(const f32x4*)(p.mlstm_norm + h * 256 + e0);
      const u32x2 mo = *(const u32x2*)(morow + e0);
      const float o0 = num[eb][4 * i4 + 0] * rstd * gn[0] * sigmf(bf_lo(mo[0]));
      const float o1 = num[eb][4 * i4 + 1] * rstd * gn[1] * sigmf(bf_hi(mo[0]));
      const float o2 = num[eb][4 * i4 + 2] * rstd * gn[2] * sigmf(bf_lo(mo[1]));
      const float o3 = num[eb][4 * i4 + 3] * rstd * gn[3] * sigmf(bf_hi(mo[1]));
      *(u32x2*)(hrow + e0) = (u32x2){pk2(o0, o1), pk2(o2, o3)};
      if ((i4 & 1) == 1) asm volatile("" ::: "memory");
    }
}

DI void attn_task(const Params& p, int task, unsigned char* smem) {
  const int h = task >> 6, qb = task & 63;
  bf16_t* sK = (bf16_t*)smem;
  int tid = threadIdx.x; asm volatile("" : "+v"(tid));
  const int lane = tid & 63, wid = tid >> 6, l32 = lane & 31, hh = lane >> 5;
  const int tq = qb * 128 + wid * 32 + l32;
  float lam, M2;
  {
    const float* lv = p.lam_vecs;
    float a = lv[lane] * lv[64 + lane], b2 = lv[128 + lane] * lv[192 + lane];
    float gq = fabsf(p.q_norm[lane]), gk = fabsf(p.k_norm[lane]);
#pragma unroll
    for (int o = 32; o >= 1; o >>= 1) { a += __shfl_xor(a, o); b2 += __shfl_xor(b2, o); gq = fmaxf(gq, __shfl_xor(gq, o)); gk = fmaxf(gk, __shfl_xor(gk, o)); }
    lam = __expf(a) - __expf(b2) + 0.2f;
    M2 = 8.0f * 1.4426950408889634f * gq * gk;
  }
  bf16x8 qf[2][4];
#pragma unroll
  for (int mp = 0; mp < 2; ++mp)
#pragma unroll
    for (int s = 0; s < 4; ++s) qf[mp][s] = *(const bf16x8*)(p.Qd + (size_t)tq * 1024 + h * 128 + mp * 64 + s * 16 + hh * 8);
  f32x16 O[2][4];
#pragma unroll
  for (int mp = 0; mp < 2; ++mp)
#pragma unroll
    for (int eb = 0; eb < 4; ++eb) O[mp][eb] = zero16();
  float ls0 = 0.f, ls1 = 0.f;
  f32x16 minit;
#pragma unroll
  for (int r = 0; r < 16; ++r) minit[r] = -M2;
  const int kr = tid >> 4, kseg = tid & 15, vr = tid >> 3, vseg = tid & 7;
  const bf16_t* kg = p.Kd + (size_t)kr * 1024 + h * 128 + kseg * 8;
  const bf16_t* vg = p.VTd + (size_t)(h * 128 + vr) * TB + vseg * 8;
  constexpr int ABUF = 64 * 136 + 128 * 72;
  u32x4 rg[8];
#define A_LOAD(Q, KT) do { if ((Q) < 4) rg[Q] = *(const u32x4*)(kg + (size_t)((KT) * 64 + 16 * (Q)) * 1024); \
                           else rg[Q] = *(const u32x4*)(vg + (size_t)(32 * ((Q) - 4)) * TB + (KT) * 64); } while (0)
#define A_STORE(Q, BASE) do { if ((Q) < 4) *(u32x4*)((BASE) + (kr + 16 * (Q)) * 136 + kseg * 8) = rg[Q]; \
                              else *(u32x4*)((BASE) + 64 * 136 + (vr + 32 * ((Q) - 4)) * 72 + vseg * 8) = rg[Q]; } while (0)
  const int NKT = TB / 64;
  __syncthreads();
#pragma unroll
  for (int q = 0; q < 8; ++q) A_LOAD(q, 0);
#pragma unroll
  for (int q = 0; q < 8; ++q) A_STORE(q, sK);
#pragma unroll
  for (int q = 0; q < 8; ++q) A_LOAD(q, 1);
  __syncthreads();
#pragma unroll 1
  for (int kt = 0; kt < NKT; ++kt) {
    const bf16_t* cK = sK + (kt & 1) * ABUF; const bf16_t* cV = cK + 64 * 136;
    bf16_t* so = sK + ((kt & 1) ^ 1) * ABUF;
    const int k2 = kt + 2 < NKT ? kt + 2 : NKT - 1;
#pragma unroll
    for (int sub = 0; sub < 2; ++sub) {
      bf16x8 pf[2][2];
#pragma unroll
      for (int mp = 0; mp < 2; ++mp) {
        f32x16 S = minit;
#pragma unroll
        for (int s = 0; s < 4; ++s) {
          const bf16x8 a = *(const bf16x8*)(cK + (sub * 32 + l32) * 136 + mp * 64 + s * 16 + hh * 8);
          S = MFMA32(a, qf[mp][s], S);
        }
        float l = 0.f;
#pragma unroll
        for (int r = 0; r < 16; ++r) { S[r] = __builtin_amdgcn_exp2f(S[r]); l += S[r]; }
        if (mp == 0) ls0 += l; else ls1 += l;
        pf[mp][0] = pack8(S, 0); pf[mp][1] = pack8(S, 1);
      }
#pragma unroll
      for (int q = sub * 4; q < sub * 4 + 4; ++q) { A_STORE(q, so); A_LOAD(q, k2); }
#pragma unroll
      for (int eb = 0; eb < 4; ++eb) {
        const bf16_t* vrp = cV + (eb * 32 + l32) * 72 + sub * 32 + 4 * hh;
        const bf16x8 v0 = cat4(*(const u32x2*)(vrp), *(const u32x2*)(vrp + 8));
        const bf16x8 v1 = cat4(*(const u32x2*)(vrp + 16), *(const u32x2*)(vrp + 24));
        O[0][eb] = MFMA32(v0, pf[0][0], O[0][eb]);
        O[1][eb] = MFMA32(v0, pf[1][0], O[1][eb]);
        O[0][eb] = MFMA32(v1, pf[0][1], O[0][eb]);
        O[1][eb] = MFMA32(v1, pf[1][1], O[1][eb]);
      }
    }
    __syncthreads();
  }
#undef A_LOAD
#undef A_STORE
  ls0 += __shfl_xor(ls0, 32); ls1 += __shfl_xor(ls1, 32);
  const float i0 = 1.0f / ls0, i1 = lam / ls1;
  float ss = 0.f;
#pragma unroll
  for (int eb = 0; eb < 4; ++eb)
#pragma unroll
    for (int r = 0; r < 16; ++r) { const float o = O[0][eb][r] * i0 - O[1][eb][r] * i1; O[0][eb][r] = o; ss += o * o; }
  ss += __shfl_xor(ss, 32);
  const float rstd = rsqrtf(ss * (1.0f / 128.0f) + 1e-6f) * 0.8f;
  bf16_t* orow = p.hB + (size_t)tq * 1024 + h * 128;
#pragma unroll
  for (int eb = 0; eb < 4; ++eb)
#pragma unroll
    for (int i4 = 0; i4 < 4; ++i4) {
      const int e0 = eb * 32 + 8 * i4 + 4 * hh;
      const f32x4 gn = *(const f32x4*)(p.diff_norm + e0);
      const f32x16& o = O[0][eb];
      *(u32x2*)(orow + e0) = (u32x2){pk2(o[4 * i4] * rstd * gn[0], o[4 * i4 + 1] * rstd * gn[1]), pk2(o[4 * i4 + 2] * rstd * gn[2], o[4 * i4 + 3] * rstd * gn[3])};
    }
}

DI void phase_merge(const Params& p, int vb, int G, unsigned char* smem) {
  EPI_COORDS(4);
  for (int t = vb; t < 32 * 8; t += G) {
    int mt, nt; tile_map(t, 8, 4, mt, nt);
    f32x16 acc[4][2];
    acc_zero(acc);
    gemm_kloop<4>(p.hA + (size_t)mt * 256 * DM, DM, p.WaT + (size_t)nt * 128 * DM, DM, DM, acc, smem);
#pragma unroll
    for (int i = 0; i < 4; ++i) {
      const int m = mt * 256 + wm * 128 + i * 32 + l32;
#pragma unroll
      for (int j = 0; j < 2; ++j)
#pragma unroll
        for (int r4 = 0; r4 < 4; ++r4) {
          const int n = nt * 128 + wn * 64 + j * 32 + 8 * r4 + 4 * hh;
          const u32x2 g = *(const u32x2*)(p.P + (size_t)m * PLD + 6144 + n);
          *(u32x2*)(p.y + (size_t)m * DM + n) = (u32x2){pk2(sigmf(bf_lo(g[0])) * acc[i][j][4 * r4 + 0], sigmf(bf_hi(g[0])) * acc[i][j][4 * r4 + 1]),
                                                        pk2(sigmf(bf_lo(g[1])) * acc[i][j][4 * r4 + 2], sigmf(bf_hi(g[1])) * acc[i][j][4 * r4 + 3])};
        }
    }
    acc_zero(acc);
    gemm_kloop<4>(p.hB + (size_t)mt * 256 * DM, DM, p.WbT + (size_t)nt * 128 * DM, DM, DM, acc, smem);
#pragma unroll
    for (int i = 0; i < 4; ++i) {
      const int m = mt * 256 + wm * 128 + i * 32 + l32;
#pragma unroll
      for (int j = 0; j < 2; ++j)
#pragma unroll
        for (int r4 = 0; r4 < 4; ++r4) {
          const int n = nt * 128 + wn * 64 + j * 32 + 8 * r4 + 4 * hh;
          const u32x2 g = *(const u32x2*)(p.P + (size_t)m * PLD + 7168 + n);
          const u32x2 y0 = *(const u32x2*)(p.y + (size_t)m * DM + n);
          const float o0 = bf_lo(y0[0]) + sigmf(bf_lo(g[0])) * acc[i][j][4 * r4 + 0], o1 = bf_hi(y0[0]) + sigmf(bf_hi(g[0])) * acc[i][j][4 * r4 + 1];
          const float o2 = bf_lo(y0[1]) + sigmf(bf_lo(g[1])) * acc[i][j][4 * r4 + 2], o3 = bf_hi(y0[1]) + sigmf(bf_hi(g[1])) * acc[i][j][4 * r4 + 3];
          *(u32x2*)(p.y + (size_t)m * DM + n) = (u32x2){pk2(o0, o1), pk2(o2, o3)};
        }
    }
  }
}

DI void phase_outproj(const Params& p, int b, int vb, int G, unsigned char* smem) {
  EPI_COORDS(4);
  for (int t = vb; t < 32 * 8; t += G) {
    int mt, nt; tile_map(t, 8, 4, mt, nt);
    f32x16 acc[4][2]; acc_zero(acc);
    gemm_kloop<4>(p.y + (size_t)mt * 256 * DM, DM, p.WoT + (size_t)nt * 128 * DM, DM, DM, acc, smem);
#pragma unroll
    for (int i = 0; i < 4; ++i) {
      const int m = mt * 256 + wm * 128 + i * 32 + l32;
      const size_t row = (size_t)(b * SEQ + m) * DM;
#pragma unroll
      for (int j = 0; j < 2; ++j)
#pragma unroll
        for (int r4 = 0; r4 < 4; ++r4) {
          const int n = nt * 128 + wn * 64 + j * 32 + 8 * r4 + 4 * hh;
          const f32x4 xv = *(const f32x4*)(p.x + row + n), g1 = *(const f32x4*)(p.mod + b * 6144 + 2048 + n);
          f32x4 o;
#pragma unroll
          for (int r = 0; r < 4; ++r) o[r] = xv[r] + g1[r] * acc[i][j][4 * r4 + r];
          *(f32x4*)(p.out + row + n) = o;
        }
    }
  }
}

template <int PROBE>
DI void phase_ffn_in(const Params& p, int vb, int G, unsigned char* smem) {
  EPI_COORDS(4);
  for (int t = vb; t < 128 * 44; t += G) {
    int mt, nt; tile_map(t, 44, 4, mt, nt);
    f32x16 acc[4][2]; acc_zero(acc);
    gemm_kloop<4>(p.xn2 + (size_t)(PROBE == 1 ? 0 : mt) * 256 * DM, DM, p.WfiT + (size_t)(PROBE == 1 ? 0 : nt) * 128 * DM, DM, DM, acc, smem);
#pragma unroll
    for (int i = 0; i < 4; ++i) {
      const int m = mt * 256 + wm * 128 + i * 32 + l32;
#pragma unroll
      for (int r4 = 0; r4 < 4; ++r4) {
        const int hc = (nt * 2 + wn) * 32 + 8 * r4 + 4 * hh;
        float o[4];
#pragma unroll
        for (int r = 0; r < 4; ++r) o[r] = siluf(acc[i][0][4 * r4 + r]) * acc[i][1][4 * r4 + r];
        bf16_t* hdst = PROBE ? p.hid + (size_t)NB * SEQ * FH + (size_t)(m & 8191) * FH : p.hid + (size_t)m * FH;
        *(u32x2*)(hdst + hc) = (u32x2){pk2(o[0], o[1]), pk2(o[2], o[3])};
      }
    }
  }
}

DI void phase_ffn_out(const Params& p, int vb, int G, unsigned char* smem) {
  EPI_COORDS(8);
  for (int t = vb; t < 128 * 4; t += G) {
    int mt, nt; tile_map(t, 4, 8, mt, nt);
    f32x16 acc[4][4]; acc_zero(acc);
    gemm_kloop<8>(p.hid + (size_t)mt * 256 * FH, FH, p.WfoT + (size_t)nt * 256 * FH, FH, FH, acc, smem);
#pragma unroll
    for (int i = 0; i < 4; ++i) {
      const int m = mt * 256 + wm * 128 + i * 32 + l32;
      const int b = m >> 13;
#pragma unroll
      for (int j = 0; j < 4; ++j)
#pragma unroll
        for (int r4 = 0; r4 < 4; ++r4) {
          const int n = nt * 256 + wn * 128 + j * 32 + 8 * r4 + 4 * hh;
          float* op = p.out + (size_t)m * DM + n;
          const f32x4 xv = *(const f32x4*)op, g2 = *(const f32x4*)(p.mod + b * 6144 + 5120 + n);
          f32x4 o;
#pragma unroll
          for (int r = 0; r < 4; ++r) o[r] = xv[r] + g2[r] * acc[i][j][4 * r4 + r];
          *(f32x4*)op = o;
        }
    }
  }
}

#define XB_TMO      128
#define XB_XCNT(j)  (256  + 64 * (j))
#define XB_XSUB(j)  (1280 + 64 * (j))
#define XB_XGEN(j)  (2304 + 64 * (j))
#define XB_TOP      3328
#define XB_TOPGEN   3392
#define XCD_BAR_WORDS 3456
#define XB_SPIN_CAP (1u << 22)
#define LAS __attribute__((address_space(3)))
DI unsigned xb_ld(unsigned* p) { return __hip_atomic_load(p, __ATOMIC_RELAXED, __HIP_MEMORY_SCOPE_AGENT); }
DI unsigned xb_add(unsigned* p, unsigned v) { return __hip_atomic_fetch_add(p, v, __ATOMIC_RELAXED, __HIP_MEMORY_SCOPE_AGENT); }
DI unsigned xb_xcc_id() { return (unsigned)__builtin_amdgcn_s_getreg((3 << 11) | 20) & 0xFu; }
#define XB_SPIN(cond, bar) do { unsigned _sp = 0; while (cond) { __builtin_amdgcn_s_sleep(1); \
    if ((++_sp & 255u) == 0u) { if (xb_ld(&(bar)[XB_TMO])) break; if (_sp > XB_SPIN_CAP) { atomicAdd(&(bar)[XB_TMO], 1u); break; } } } } while (0)
struct XcdBarrier { unsigned* bar; unsigned x; volatile LAS unsigned* st; };
DI XcdBarrier xcd_barrier_post(unsigned* bar, volatile LAS unsigned* st) {
  XcdBarrier b; b.bar = bar; b.x = xb_xcc_id(); b.st = st;
  if (threadIdx.x == 0) st[2] = xb_add(&bar[XB_XCNT(b.x)], 1u);
  return b;
}
DI void xcd_barrier_complete(unsigned* bar, unsigned x, unsigned& nloc, unsigned& nx) {
  const unsigned G = gridDim.x * gridDim.y * gridDim.z;
  unsigned sum, cnt, mine, sp = 0u;
  for (;;) {
    sum = 0u; cnt = 0u; mine = 0u;
#pragma unroll
    for (unsigned j = 0; j < 16; ++j) { const unsigned c = xb_ld(&bar[XB_XCNT(j)]); sum += c; cnt += (c > 0u) ? 1u : 0u; mine = (j == x) ? c : mine; }
    if (sum == G) break;
    __builtin_amdgcn_s_sleep(1);
    if ((++sp & 255u) == 0u) { if (xb_ld(&bar[XB_TMO])) break; if (sp > XB_SPIN_CAP) { atomicAdd(&bar[XB_TMO], 1u); break; } }
  }
  nloc = mine > 0u ? mine : 1u; nx = cnt > 0u ? cnt : 1u;
}
DI void xcd_barrier(const XcdBarrier& b) {
  asm volatile("s_waitcnt vmcnt(0)" ::: "memory");
  __syncthreads();
  if (threadIdx.x == 0) {
    unsigned* bar = b.bar;
    __builtin_amdgcn_s_waitcnt(0);
    unsigned nloc = b.st[0], nx = b.st[1];
    if (nloc == 0u) { xcd_barrier_complete(bar, b.x, nloc, nx); b.st[0] = nloc; b.st[1] = nx; }
    const unsigned old = xb_add(&bar[XB_XSUB(b.x)], 1u);
    const unsigned gen = old / nloc;
    if (old + 1u == (gen + 1u) * nloc) {
      __builtin_amdgcn_fence(__ATOMIC_RELEASE, "agent");
      asm volatile("s_waitcnt vmcnt(0)" ::: "memory");
      const unsigned og = xb_add(&bar[XB_TOP], 1u);
      const unsigned tg = og / nx;
      if (og + 1u == (tg + 1u) * nx) xb_add(&bar[XB_TOPGEN], 1u);
      else XB_SPIN(xb_ld(&bar[XB_TOPGEN]) == tg, bar);
      __builtin_amdgcn_fence(__ATOMIC_ACQUIRE, "agent");
      xb_add(&bar[XB_XGEN(b.x)], 1u);
      asm volatile("s_waitcnt vmcnt(0)" ::: "memory");
    } else {
      XB_SPIN(xb_ld(&bar[XB_XGEN(b.x)]) == gen, bar);
      __builtin_amdgcn_fence(__ATOMIC_ACQUIRE, "agent");
      asm volatile("s_waitcnt vmcnt(0)" ::: "memory");
    }
  }
  __syncthreads();
}

#ifndef PHMASK
#define PHMASK 0xFFFF
#endif
#define PH(n) ((PHMASK >> (n)) & 1)
#ifndef REPMASK
#define REPMASK 0
#endif
#define NREP(n) (1 + ((REPMASK >> (n)) & 1))
#define GSYNC() do { xcd_barrier(xb); if ((REPMASK >> 15) & 1) xcd_barrier(xb); } while (0)
__global__ void __launch_bounds__(256, 1) hybrid_block_megakernel(Params p) {
  cg::grid_group grid = cg::this_grid();
  __shared__ __attribute__((aligned(16))) unsigned char smem[SMEM_BYTES];
  const int G = gridDim.x, bid = blockIdx.x;
  int vb = bid;
  const int wid = threadIdx.x >> 6;
  __shared__ __attribute__((aligned(16))) unsigned xb_words[4];
  if (threadIdx.x < 4) xb_words[threadIdx.x] = 0u;
  __syncthreads();
  const XcdBarrier xb = xcd_barrier_post(p.bar, (volatile LAS unsigned*)xb_words);

  if (PH(0)) phase0(p, vb, G, smem);
  grid.sync();
  GSYNC();
  if (threadIdx.x == 0) {
    bool even = (G % 8) == 0 && xb.x < 8u;
    for (unsigned j = 0; j < 16; ++j) { const unsigned cnt = xb_ld(&p.bar[XB_XCNT(j)]); if (cnt != (j < 8u ? (unsigned)(G / 8) : 0u)) even = false; }
    xb_words[3] = even ? 1u : 0u;
  }
  __syncthreads();
  if (xb_words[3]) vb = (int)xb.x * (G / 8) + (int)xb_words[2];
  for (int t = vb; t < NB * TB / 8; t += G) {
    const int R0 = t * 8 + wid * 2;
    const float* src[2]; const float* md[2];
#pragma unroll
    for (int z = 0; z < 2; ++z) {
      const int R = R0 + z, b = R / TB, tau = R % TB;
      src[z] = tau < SEQ ? p.x + (size_t)(b * SEQ + tau) * DM : p.ctx + (size_t)(b * CTXL + tau - SEQ) * DM;
      md[z] = p.mod + (tau < SEQ ? b : 4) * 6144;
    }
    norm_row2(src[0], src[1], p.norm1, md[0], md[0] + 1024, md[1], md[1] + 1024, p.xn + (size_t)R0 * DM, p.xn + (size_t)(R0 + 1) * DM);
  }
  GSYNC();
  for (int b = -1; b < NB; ++b) {
   if (b >= 0) {
    for (int rep = 0; rep < NREP(2); ++rep) {
      if (PH(2)) phase_prep(p, b, vb, G, smem);
      GSYNC();
    }
    for (int rep = 0; rep < NREP(3); ++rep) {
      if (PH(3)) phase_mlstm_u(p, vb, G, smem);
      GSYNC();
      if (PH(4)) phase_mlstm_scan(p, vb, G);
      GSYNC();
    }
    for (int rep = 0; rep < NREP(5); ++rep) {
      for (int t = vb; t < 512; t += G) { if (PH(5)) attn_task(p, t, smem); }
    }
    for (int rep = 0; rep < NREP(6); ++rep) {
      for (int t = vb; t < 256; t += G) { if (PH(6)) mlstm_out_task(p, t, smem); }
    }
    GSYNC();
    for (int rep = 0; rep < NREP(7); ++rep) {
      if (PH(7)) phase_merge(p, vb, G, smem);
      GSYNC();
      if (PH(8)) phase_outproj(p, b, vb, G, smem);
    }
   }
    if (b + 1 < NB && PH(1)) phase_inproj(p, b + 1, vb, G, smem);
    GSYNC();
  }
  for (int t = vb; t < NB * SEQ / 8; t += G) {
    const int R0 = t * 8 + wid * 2, b = R0 >> 13;
    const float* md = p.mod + b * 6144;
    norm_row2(p.out + (size_t)R0 * DM, p.out + (size_t)(R0 + 1) * DM, p.norm2, md + 3072, md + 4096, md + 3072, md + 4096, p.xn2 + (size_t)R0 * DM, p.xn2 + (size_t)(R0 + 1) * DM);
  }
  GSYNC();
  for (int rep = 0; rep < NREP(9); ++rep) {
    if (PH(9)) phase_ffn_in<0>(p, vb, G, smem);
    GSYNC();
  }

  if (PH(10)) phase_ffn_out(p, vb, G, smem);
}

extern "C" void kernel_launch(void* const* d_in, const int* in_sizes, int n_in, void* d_out, int out_size, void* d_ws, size_t ws_size,
                              hipStream_t stream) {
  static int grid_blocks = 0;
  if (!grid_blocks) {
    int dev = 0, cus = 0, per_cu = 0;
    (void)hipGetDevice(&dev);
    (void)hipDeviceGetAttribute(&cus, hipDeviceAttributeMultiprocessorCount, dev);
    (void)hipOccupancyMaxActiveBlocksPerMultiprocessor(&per_cu, hybrid_block_megakernel, 256, 0);
    if (per_cu > 1) per_cu = 1;
    grid_blocks = cus * per_cu;
  }
  Params p{};
  const float* const* in = (const float* const*)d_in;
  p.x = in[0]; p.c = in[1]; p.ctx = in[2]; p.c_ctx = in[3]; p.w_mod = in[4]; p.b_mod = in[5]; p.norm1 = in[6]; p.norm2 = in[7];
  p.w_in = in[8]; p.b_gate = in[9]; p.conv_w = in[10]; p.conv_b = in[11]; p.mlstm_norm = in[12]; p.q_norm = in[13]; p.k_norm = in[14];
  p.lam_vecs = in[15]; p.diff_norm = in[16]; p.w_a = in[17]; p.w_b = in[18]; p.w_out = in[19]; p.w_ffn_in = in[20]; p.w_ffn_out = in[21];
  p.out = (float*)d_out;
  unsigned char* ws = (unsigned char*)d_ws;
  size_t off = 0;
  auto take = [&](size_t bytes) { unsigned char* r = ws + off; off += (bytes + 255) & ~(size_t)255; return r; };
  p.bar = (unsigned*)take((size_t)XCD_BAR_WORDS * 4);
  (void)hipMemsetAsync(p.bar, 0, (size_t)XCD_BAR_WORDS * 4, stream);
  p.WinT = (bf16_t*)take((size_t)NWIN * 1024 * 2);
  p.WaT = (bf16_t*)take((size_t)1024 * 1024 * 2);
  p.WbT = (bf16_t*)take((size_t)1024 * 1024 * 2);
  p.WoT = (bf16_t*)take((size_t)1024 * 1024 * 2);
  p.WfiT = (bf16_t*)take((size_t)2 * FH * 1024 * 2);
  p.WfoT = (bf16_t*)take((size_t)1024 * FH * 2);
  p.mod = (float*)take((size_t)5 * 6144 * 4);
  p.rope = (float*)take((size_t)128 * 16 * 2 * 4);
  p.xn = (bf16_t*)take((size_t)NB * TB * DM * 2);
  const size_t r0 = off;
  p.P = (bf16_t*)take((size_t)TB * PLD * 2);
  p.gates = (float*)take((size_t)TB * 16 * 4);
  p.Qm = (bf16_t*)take((size_t)TB * 512 * 2);
  p.Km = (bf16_t*)take((size_t)TB * 512 * 2);
  p.KTm = (bf16_t*)take((size_t)512 * TB * 2);
  p.VTm = (bf16_t*)take((size_t)1024 * TB * 2);
  p.Qd = (bf16_t*)take((size_t)SEQ * 1024 * 2);
  p.Kd = (bf16_t*)take((size_t)TB * 1024 * 2);
  p.VTd = (bf16_t*)take((size_t)1024 * TB * 2);
  p.scal = (float*)take((size_t)8 * NSTEP * 256 * 4 * 4);
  p.stepsc = (float*)take((size_t)8 * NSTEP * 2 * 4);
  p.ST = (bf16_t*)take((size_t)8 * NSTEP * STROWS * 128 * 2);
  p.hA = (bf16_t*)take((size_t)SEQ * 1024 * 2);
  p.hB = (bf16_t*)take((size_t)SEQ * 1024 * 2);
  p.y = (bf16_t*)take((size_t)SEQ * 1024 * 2);
  p.xn2 = (bf16_t*)(ws + r0);
  p.hid = (bf16_t*)(ws + r0 + (size_t)NB * SEQ * DM * 2);
  if (off > ws_size || r0 + (size_t)NB * SEQ * DM * 2 + (size_t)NB * SEQ * FH * 2 > ws_size) fprintf(stderr, "workspace too small: need %zu have %zu\n", off, ws_size);
  void* args[] = {&p};
  hipError_t e = hipLaunchCooperativeKernel((void*)hybrid_block_megakernel, dim3(grid_blocks), dim3(256), args, 0, stream);
  if (e != hipSuccess) fprintf(stderr, "cooperative launch failed: %s (grid %d)\n", hipGetErrorString(e), grid_blocks);
}
```

```cpp
#include <hip/hip_runtime.h>
#include <hip/hip_cooperative_groups.h>
#include <cstdio>
#include <cstdint>
namespace cg = cooperative_groups;

#define DI __device__ __forceinline__
typedef unsigned short bf16_t;
typedef short bf16x8 __attribute__((ext_vector_type(8)));
typedef short bf16x4 __attribute__((ext_vector_type(4)));
typedef float f32x2 __attribute__((ext_vector_type(2)));
typedef float f32x4 __attribute__((ext_vector_type(4)));
typedef float f32x16 __attribute__((ext_vector_type(16)));
typedef unsigned u32x2 __attribute__((ext_vector_type(2)));
typedef unsigned u32x4 __attribute__((ext_vector_type(4)));
typedef __bf16 bfv2 __attribute__((ext_vector_type(2)));

constexpr int DM = 1024, NB = 4, SEQ = 8192, CTXL = 256, TB = SEQ + CTXL;
constexpr int PW = 8192;
constexpr int PLD = PW + 64;
constexpr int NWIN = 8448;
constexpr int FH = 2816;
constexpr int NSTEP = 33;
constexpr int STROWS = 288;
constexpr int SMEM_BYTES = 147456;

struct Params {
  const float *x, *c, *ctx, *c_ctx, *w_mod, *b_mod, *norm1, *norm2, *w_in, *b_gate, *conv_w, *conv_b, *mlstm_norm,
      *q_norm, *k_norm, *lam_vecs, *diff_norm, *w_a, *w_b, *w_out, *w_ffn_in, *w_ffn_out;
  float* out;
  bf16_t *WinT, *WaT, *WbT, *WoT, *WfiT, *WfoT;
  float *mod, *rope;
  bf16_t *xn, *P;
  float* gates;
  bf16_t *Qm, *Km, *KTm, *VTm, *Qd, *Kd, *VTd;
  float *scal, *stepsc;
  bf16_t *ST, *hA, *hB, *y, *xn2, *hid;
  unsigned* bar;
};

DI unsigned pk2(float a, float b) { f32x2 v = {a, b}; return __builtin_bit_cast(unsigned, __builtin_convertvector(v, bfv2)); }
DI bf16_t f2bf(float a) { return (bf16_t)(pk2(a, 0.f) & 0xffffu); }
DI float bf_lo(unsigned u) { return __uint_as_float(u << 16); }
DI float bf_hi(unsigned u) { return __uint_as_float(u & 0xffff0000u); }
DI float bf2f(bf16_t u) { return __uint_as_float(((unsigned)u) << 16); }
DI float siluf(float x) { return x * __builtin_amdgcn_rcpf(1.f + __expf(-x)); }
DI float sigmf(float x) { return __builtin_amdgcn_rcpf(1.f + __expf(-x)); }
DI f32x16 zero16() { f32x16 z; for (int i = 0; i < 16; ++i) z[i] = 0.f; return z; }
DI f32x4 zero4() { f32x4 z = {0.f, 0.f, 0.f, 0.f}; return z; }
#define MFMA32(a, b, c) __builtin_amdgcn_mfma_f32_32x32x16_bf16((a), (b), (c), 0, 0, 0)
#define MFMA16(a, b, c) __builtin_amdgcn_mfma_f32_16x16x32_bf16((a), (b), (c), 0, 0, 0)

DI bf16x8 pack8(const f32x16& x, int s) {
  u32x4 p;
  p[0] = pk2(x[8 * s + 0], x[8 * s + 1]); p[1] = pk2(x[8 * s + 2], x[8 * s + 3]);
  p[2] = pk2(x[8 * s + 4], x[8 * s + 5]); p[3] = pk2(x[8 * s + 6], x[8 * s + 7]);
  return __builtin_bit_cast(bf16x8, p);
}
DI bf16x8 cat4(u32x2 a, u32x2 b) { u32x4 p = {a[0], a[1], b[0], b[1]}; return __builtin_bit_cast(bf16x8, p); }

DI int srccol_win(int j) { if (j < 3072) return j; if (j < 8192) return j + 16; if (j < 8208) return 3072 + (j - 8192); return -1; }
DI int srccol_ffi(int r) { const int g = r >> 6, rr = r & 63; return rr < 32 ? g * 32 + rr : FH + g * 32 + (rr - 32); }

DI void wt_tile(const float* __restrict__ src, int ldsrc, int K, bf16_t* __restrict__ dst, int n0, int k0, int mode, bf16_t* sm) {
  const int t = threadIdx.x, nl = t & 63, kb = t >> 6;
  const int j = n0 + nl;
  const int sc = mode == 1 ? srccol_win(j) : (mode == 2 ? srccol_ffi(j) : j);
#pragma unroll 4
  for (int pss = 0; pss < 16; ++pss) {
    const int k = kb + 4 * pss;
    const float v = sc >= 0 ? src[(size_t)(k0 + k) * ldsrc + sc] : 0.f;
    sm[k * 66 + nl] = f2bf(v);
  }
  __syncthreads();
  const int n = t >> 2, ks = (t & 3) * 16;
  unsigned w[8];
#pragma unroll
  for (int i = 0; i < 8; ++i) w[i] = (unsigned)sm[(ks + 2 * i) * 66 + n] | ((unsigned)sm[(ks + 2 * i + 1) * 66 + n] << 16);
  u32x4* d = (u32x4*)(dst + (size_t)(n0 + n) * K + k0 + ks);
  d[0] = (u32x4){w[0], w[1], w[2], w[3]};
  d[1] = (u32x4){w[4], w[5], w[6], w[7]};
  __syncthreads();
}

DI void mod_task(const Params& p, int task, float* smf) {
  const int tid = threadIdx.x;
  for (int idx = tid; idx < 5 * 1024; idx += 256) {
    const int r = idx >> 10, k = idx & 1023;
    const float v = r < 4 ? p.c[r * 1024 + k] : p.c_ctx[k];
    smf[idx] = siluf(v);
  }
  __syncthreads();
  const int col = tid & 31, kg = tid >> 5, n = task * 32 + col;
  float acc[5] = {0.f, 0.f, 0.f, 0.f, 0.f};
  for (int k = kg * 128; k < kg * 128 + 128; ++k) {
    const float w = p.w_mod[(size_t)k * 6144 + n];
#pragma unroll
    for (int r = 0; r < 5; ++r) acc[r] += smf[r * 1024 + k] * w;
  }
  float* red = smf + 5120;
#pragma unroll
  for (int r = 0; r < 5; ++r) red[(kg * 32 + col) * 5 + r] = acc[r];
  __syncthreads();
  if (tid < 160) {
    const int r = tid >> 5, cc = tid & 31;
    float s = 0.f;
    for (int g = 0; g < 8; ++g) s += red[(g * 32 + cc) * 5 + r];
    p.mod[r * 6144 + task * 32 + cc] = s + p.b_mod[task * 32 + cc];
  }
  __syncthreads();
}

DI void phase0(const Params& p, int vb, int G, unsigned char* smem) {
  const int nWin = 132 * 16, nSq = 16 * 16, nFi = 88 * 16, nFo = 16 * 44;
  const int total = 193 + nWin + 3 * nSq + nFi + nFo;
  for (int t = vb; t < total; t += G) {
    if (t < 192) { mod_task(p, t, (float*)smem); continue; }
    if (t == 192) {
      for (int idx = threadIdx.x; idx < 128 * 16; idx += 256) {
        const int pos = idx >> 4, f = idx & 15;
        const float inv = exp2f(-(float)f * (13.287712379549449f / 16.0f));
        const float ang = (float)pos * inv;
        float rev = ang * 0.15915494309189535f; rev -= floorf(rev);
        p.rope[idx * 2 + 0] = __builtin_amdgcn_cosf(rev);
        p.rope[idx * 2 + 1] = __builtin_amdgcn_sinf(rev);
      }
      continue;
    }
    int u = t - 193;
    bf16_t* sm = (bf16_t*)smem;
    if (u < nWin) { wt_tile(p.w_in, 8208, 1024, p.WinT, (u >> 4) * 64, (u & 15) * 64, 1, sm); continue; }
    u -= nWin;
    if (u < nSq) { wt_tile(p.w_a, 1024, 1024, p.WaT, (u >> 4) * 64, (u & 15) * 64, 0, sm); continue; }
    u -= nSq;
    if (u < nSq) { wt_tile(p.w_b, 1024, 1024, p.WbT, (u >> 4) * 64, (u & 15) * 64, 0, sm); continue; }
    u -= nSq;
    if (u < nSq) { wt_tile(p.w_out, 1024, 1024, p.WoT, (u >> 4) * 64, (u & 15) * 64, 0, sm); continue; }
    u -= nSq;
    if (u < nFi) { wt_tile(p.w_ffn_in, 2 * FH, 1024, p.WfiT, (u >> 4) * 64, (u & 15) * 64, 2, sm); continue; }
    u -= nFi;
    wt_tile(p.w_ffn_out, 1024, FH, p.WfoT, (u / 44) * 64, (u % 44) * 64, 0, sm);
  }
}

DI void norm_row2(const float* __restrict__ srcA, const float* __restrict__ srcB, const float* __restrict__ gain, const float* __restrict__ shA, const float* __restrict__ scA,
                  const float* __restrict__ shB, const float* __restrict__ scB, bf16_t* __restrict__ dstA, bf16_t* __restrict__ dstB) {
  const int lane = threadIdx.x & 63;
  f32x4 va[4], vb2[4];
  float sa = 0.f, sb = 0.f;
#pragma unroll
  for (int i = 0; i < 4; ++i) { va[i] = *(const f32x4*)(srcA + (i * 64 + lane) * 4); vb2[i] = *(const f32x4*)(srcB + (i * 64 + lane) * 4); }
#pragma unroll
  for (int i = 0; i < 4; ++i) {
    sa += va[i][0] * va[i][0] + va[i][1] * va[i][1] + va[i][2] * va[i][2] + va[i][3] * va[i][3];
    sb += vb2[i][0] * vb2[i][0] + vb2[i][1] * vb2[i][1] + vb2[i][2] * vb2[i][2] + vb2[i][3] * vb2[i][3];
  }
#pragma unroll
  for (int o = 32; o >= 1; o >>= 1) { sa += __shfl_xor(sa, o); sb += __shfl_xor(sb, o); }
  const float ra = rsqrtf(sa * (1.0f / 1024.0f) + 1e-6f), rb = rsqrtf(sb * (1.0f / 1024.0f) + 1e-6f);
#pragma unroll
  for (int i = 0; i < 4; ++i) {
    const int k = (i * 64 + lane) * 4;
    const f32x4 g = *(const f32x4*)(gain + k);
    const f32x4 a1 = *(const f32x4*)(scA + k), a0 = *(const f32x4*)(shA + k), b1 = *(const f32x4*)(scB + k), b0 = *(const f32x4*)(shB + k);
    float oa[4], ob[4];
#pragma unroll
    for (int r = 0; r < 4; ++r) { oa[r] = va[i][r] * ra * g[r] * (1.f + a1[r]) + a0[r]; ob[r] = vb2[i][r] * rb * g[r] * (1.f + b1[r]) + b0[r]; }
    *(u32x2*)(dstA + k) = (u32x2){pk2(oa[0], oa[1]), pk2(oa[2], oa[3])};
    *(u32x2*)(dstB + k) = (u32x2){pk2(ob[0], ob[1]), pk2(ob[2], ob[3])};
  }
}

template <int NJ, bool SWAP = false>
DI void gemm_kloop(const bf16_t* __restrict__ A, int lda, const bf16_t* __restrict__ Bt, int ldb, int K, f32x16 (&acc)[4][NJ / 2], unsigned char* smem) {
  constexpr int BN = 32 * NJ, NBQ = BN / 32, NSL = 8 + NBQ, QPS = (NSL + 3) / 4, BUF = (256 + BN) * 72;
  int tid = threadIdx.x; asm volatile("" : "+v"(tid));
  const int lane = tid & 63, wid = tid >> 6, wm = wid >> 1, wn = wid & 1;
  const int l32 = lane & 31, hh = lane >> 5;
  const int lr = tid >> 3, lc = (tid & 7) * 8;
  const bf16_t* ap = A + (size_t)lr * lda + lc;
  const bf16_t* bp = Bt + (size_t)lr * ldb + lc;
  bf16_t* s0 = (bf16_t*)smem;
  u32x4 rg[NSL];
  const int nk = K >> 6;
#define SL_LOAD(Q, KT) do { if ((Q) < 8) rg[Q] = *(const u32x4*)(ap + (KT) * 64 + (size_t)(Q) * 32 * lda); \
                            else rg[Q] = *(const u32x4*)(bp + (KT) * 64 + (size_t)((Q) - 8) * 32 * ldb); } while (0)
#define SL_STORE(Q, BASE) do { if ((Q) < 8) *(u32x4*)((BASE) + (lr + 32 * (Q)) * 72 + lc) = rg[Q]; \
                               else *(u32x4*)((BASE) + 256 * 72 + (lr + 32 * ((Q) - 8)) * 72 + lc) = rg[Q]; } while (0)
#pragma unroll
  for (int q = 0; q < NSL; ++q) SL_LOAD(q, 0);
#pragma unroll
  for (int q = 0; q < NSL; ++q) SL_STORE(q, s0);
  {
    const int k1 = nk > 1 ? 1 : 0;
#pragma unroll
    for (int q = 0; q < NSL; ++q) SL_LOAD(q, k1);
  }
  __syncthreads();
#pragma unroll 1
  for (int kt = 0; kt < nk; ++kt) {
    const bf16_t* sa = s0 + (kt & 1) * BUF; const bf16_t* sb = sa + 256 * 72;
    bf16_t* so = s0 + ((kt & 1) ^ 1) * BUF;
    const int k2 = kt + 2 < nk ? kt + 2 : nk - 1;
    bf16x8 af[2][4], bfr[2][NJ / 2];
#pragma unroll
    for (int i = 0; i < 4; ++i) af[0][i] = *(const bf16x8*)(sa + (wm * 128 + i * 32 + l32) * 72 + hh * 8);
#pragma unroll
    for (int j = 0; j < NJ / 2; ++j) bfr[0][j] = *(const bf16x8*)(sb + (wn * 16 * NJ + j * 32 + l32) * 72 + hh * 8);
#pragma unroll
    for (int ks = 0; ks < 4; ++ks) {
      if (ks < 3) {
#pragma unroll
        for (int i = 0; i < 4; ++i) af[(ks + 1) & 1][i] = *(const bf16x8*)(sa + (wm * 128 + i * 32 + l32) * 72 + (ks + 1) * 16 + hh * 8);
#pragma unroll
        for (int j = 0; j < NJ / 2; ++j) bfr[(ks + 1) & 1][j] = *(const bf16x8*)(sb + (wn * 16 * NJ + j * 32 + l32) * 72 + (ks + 1) * 16 + hh * 8);
      }
#pragma unroll
      for (int q = ks * QPS; q < (ks + 1) * QPS && q < NSL; ++q) { SL_STORE(q, so); SL_LOAD(q, k2); }
#pragma unroll
      for (int i = 0; i < 4; ++i)
#pragma unroll
        for (int j = 0; j < NJ / 2; ++j) acc[i][j] = SWAP ? MFMA32(af[ks & 1][i], bfr[ks & 1][j], acc[i][j]) : MFMA32(bfr[ks & 1][j], af[ks & 1][i], acc[i][j]);
#pragma unroll
      for (int g = 0; g < 4 * (NJ / 2); ++g) {
        __builtin_amdgcn_sched_group_barrier(0x008, 1, 0);
        if (ks < 3 && g < 4 + NJ / 2) __builtin_amdgcn_sched_group_barrier(0x100, 1, 0);
        if (g < QPS) { __builtin_amdgcn_sched_group_barrier(0x200, 1, 0); __builtin_amdgcn_sched_group_barrier(0x020, 1, 0); }
      }
      __builtin_amdgcn_sched_barrier(0);
    }
    __syncthreads();
  }
#undef SL_LOAD
#undef SL_STORE
}
template <int NJ2>
DI void acc_zero(f32x16 (&acc)[4][NJ2]) {
#pragma unroll
  for (int i = 0; i < 4; ++i)
#pragma unroll
    for (int j = 0; j < NJ2; ++j) acc[i][j] = zero16();
}
#define EPI_COORDS(NJ) int tid = threadIdx.x; asm volatile("" : "+v"(tid)); const int lane = tid & 63, wid = tid >> 6, wm = wid >> 1, wn = wid & 1, l32 = lane & 31, hh = lane >> 5
DI void tile_map(int t, int NTn, int GM, int& mt, int& nt) { const int per = GM * NTn, g = t / per, r = t % per; mt = g * GM + r % GM; nt = r / GM; }

DI void phase_inproj(const Params& p, int b, int vb, int G, unsigned char* smem) {
  EPI_COORDS(4);
  const int MT = 33, NTn = 66;
  const bf16_t* A = p.xn + (size_t)b * TB * DM;
  for (int t = vb; t < MT * NTn; t += G) {
    int mt, nt; tile_map(t, NTn, 3, mt, nt);
    const int reg = nt >> 3;
    if (nt == 65 || (mt == 32 && (reg == 2 || reg == 3 || reg == 6 || reg == 7))) continue;
    if (nt < 65 && (reg == 1 || reg == 5)) {
      f32x16 acc[4][2]; acc_zero(acc);
      gemm_kloop<4, true>(A + (size_t)mt * 256 * DM, DM, p.WinT + (size_t)nt * 128 * DM, DM, DM, acc, smem);
      bf16_t* dstT = reg == 1 ? p.VTm : p.VTd;
      bf16_t* sT2 = (bf16_t*)smem;
#pragma unroll
      for (int i = 0; i < 4; ++i)
#pragma unroll
        for (int j = 0; j < 2; ++j)
#pragma unroll
          for (int r4 = 0; r4 < 4; ++r4)
            *(u32x2*)(sT2 + (wn * 64 + j * 32 + l32) * 264 + wm * 128 + i * 32 + 8 * r4 + 4 * hh) =
                (u32x2){pk2(acc[i][j][4 * r4], acc[i][j][4 * r4 + 1]), pk2(acc[i][j][4 * r4 + 2], acc[i][j][4 * r4 + 3])};
      __syncthreads();
      {
        const int rrow = tid >> 5, ch = tid & 31;
        bf16_t* dbase = dstT + (size_t)((nt & 7) * 128) * TB + mt * 256 + ch * 8;
#pragma unroll 2
        for (int q = 0; q < 16; ++q) {
          const int row = rrow + 8 * q;
          *(u32x4*)(dbase + (size_t)row * TB) = *(const u32x4*)(sT2 + row * 264 + ch * 8);
        }
      }
      __syncthreads();
      continue;
    }
    f32x16 acc[4][2]; acc_zero(acc);
    gemm_kloop<4>(A + (size_t)mt * 256 * DM, DM, p.WinT + (size_t)nt * 128 * DM, DM, DM, acc, smem);
    if (reg == 3 || reg == 4) {
      const bool isq = reg == 3;
      if (isq && mt == 32) continue;
      const float* gn = isq ? p.q_norm : p.k_norm;
      bf16_t* dst = isq ? p.Qd : p.Kd;
      const int c0 = (nt & 7) * 128 + wn * 64;
      const float osc = isq ? 0.125f * 1.4426950408889634f : 1.0f;
#pragma unroll
      for (int i = 0; i < 4; ++i) {
        const int tau = mt * 256 + wm * 128 + i * 32 + l32;
        float ss = 0.f;
#pragma unroll
        for (int j = 0; j < 2; ++j)
#pragma unroll
          for (int r = 0; r < 16; ++r) ss += acc[i][j][r] * acc[i][j][r];
        ss += __shfl_xor(ss, 32);
        const float rstd = rsqrtf(ss * (1.0f / 64.0f) + 1e-6f);
#pragma unroll
        for (int j = 0; j < 2; ++j) {
          float v[16];
#pragma unroll
          for (int r4 = 0; r4 < 4; ++r4) {
            const f32x4 g4 = *(const f32x4*)(gn + j * 32 + 8 * r4 + 4 * hh);
#pragma unroll
            for (int r = 0; r < 4; ++r) v[4 * r4 + r] = acc[i][j][4 * r4 + r] * rstd * g4[r];
          }
          if (mt < 32) {
            const int pos = j == 0 ? (tau >> 6) : (tau & 63);
            const float* rp = p.rope + pos * 32;
#pragma unroll
            for (int r4 = 0; r4 < 2; ++r4) {
              const f32x4 cs0 = *(const f32x4*)(rp + 2 * (8 * r4 + 4 * hh)), cs1 = *(const f32x4*)(rp + 2 * (8 * r4 + 4 * hh) + 4);
              const float cs[8] = {cs0[0], cs0[1], cs0[2], cs0[3], cs1[0], cs1[1], cs1[2], cs1[3]};
#pragma unroll
              for (int r = 0; r < 4; ++r) {
                const float x1 = v[4 * r4 + r], x2 = v[4 * (r4 + 2) + r], c = cs[2 * r], sn = cs[2 * r + 1];
                v[4 * r4 + r] = x1 * c - x2 * sn; v[4 * (r4 + 2) + r] = x2 * c + x1 * sn;
              }
            }
          }
#pragma unroll
          for (int r4 = 0; r4 < 4; ++r4)
            *(u32x2*)((bf16_t*)smem + (wm * 128 + i * 32 + l32) * 136 + wn * 64 + j * 32 + 8 * r4 + 4 * hh) = (u32x2){pk2(v[4 * r4] * osc, v[4 * r4 + 1] * osc), pk2(v[4 * r4 + 2] * osc, v[4 * r4 + 3] * osc)};
        }
      }
      __syncthreads();
      {
        const int rrow = tid >> 4, ch = tid & 15;
        bf16_t* dbase = dst + (size_t)(mt * 256) * 1024 + (nt & 7) * 128 + ch * 8;
#pragma unroll 2
        for (int q = 0; q < 16; ++q) {
          const int row = rrow + 16 * q;
          *(u32x4*)(dbase + (size_t)row * 1024) = *(const u32x4*)((const bf16_t*)smem + row * 136 + ch * 8);
        }
      }
      __syncthreads();
      continue;
    }
    bf16_t* sT = (bf16_t*)smem;
    if (nt < 64) {
#pragma unroll
      for (int i = 0; i < 4; ++i)
#pragma unroll
        for (int j = 0; j < 2; ++j)
#pragma unroll
          for (int r4 = 0; r4 < 4; ++r4)
            *(u32x2*)(sT + (wm * 128 + i * 32 + l32) * 136 + wn * 64 + j * 32 + 8 * r4 + 4 * hh) =
                (u32x2){pk2(acc[i][j][4 * r4], acc[i][j][4 * r4 + 1]), pk2(acc[i][j][4 * r4 + 2], acc[i][j][4 * r4 + 3])};
      __syncthreads();
      {
        const int rrow = tid >> 4, ch = tid & 15;
        bf16_t* dbase = p.P + (size_t)(mt * 256) * PLD + nt * 128 + ch * 8;
#pragma unroll 2
        for (int q = 0; q < 16; ++q) {
          const int row = rrow + 16 * q;
          *(u32x4*)(dbase + (size_t)row * PLD) = *(const u32x4*)(sT + row * 136 + ch * 8);
        }
      }
      if (reg != 0) { __syncthreads(); continue; }
    }
    if (reg == 0) {
      const int cg = tid & 31, tg = tid >> 5, c0 = nt * 128 + cg * 4, t0 = tg * 32;
      float w[5][4], bias[4];
#pragma unroll
      for (int j = 0; j < 5; ++j) {
        const f32x4 a0 = *(const f32x4*)(p.conv_w + j * 1024 + c0);
#pragma unroll
        for (int e = 0; e < 4; ++e) w[j][e] = a0[e];
      }
      {
        const f32x4 a0 = *(const f32x4*)(p.conv_b + c0);
#pragma unroll
        for (int e = 0; e < 4; ++e) bias[e] = a0[e];
      }
      const float osc = nt < 4 ? 0.08838834764831845f : 1.0f;
      float win[5][4];
#pragma unroll
      for (int j = 0; j < 4; ++j) {
        int rr = t0 - 2 + j; rr = rr < 0 ? 0 : rr;
        const u32x2 v = *(const u32x2*)(sT + rr * 136 + cg * 4);
        win[j + 1][0] = bf_lo(v[0]); win[j + 1][1] = bf_hi(v[0]); win[j + 1][2] = bf_lo(v[1]); win[j + 1][3] = bf_hi(v[1]);
      }
      unsigned outp[4][4];
#pragma unroll
      for (int tt = 0; tt < 32; ++tt) {
#pragma unroll
        for (int j = 0; j < 4; ++j)
#pragma unroll
          for (int e = 0; e < 4; ++e) win[j][e] = win[j + 1][e];
        int rr = t0 + tt + 2; rr = rr > 255 ? 255 : rr;
        const u32x2 v = *(const u32x2*)(sT + rr * 136 + cg * 4);
        win[4][0] = bf_lo(v[0]); win[4][1] = bf_hi(v[0]); win[4][2] = bf_lo(v[1]); win[4][3] = bf_hi(v[1]);
        float o[4];
#pragma unroll
        for (int e = 0; e < 4; ++e) {
          float a = bias[e];
#pragma unroll
          for (int j = 0; j < 5; ++j) a += win[j][e] * w[j][e];
          o[e] = siluf(a) * osc;
        }
        const int tau = mt * 256 + t0 + tt;
        const u32x2 pk = {pk2(o[0], o[1]), pk2(o[2], o[3])};
        if (nt < 4) *(u32x2*)(p.Qm + (size_t)tau * 512 + c0) = pk;
        else {
          *(u32x2*)(p.Km + (size_t)tau * 512 + (c0 - 512)) = pk;
#pragma unroll
          for (int e = 0; e < 4; ++e) {
            const unsigned hv = (e & 1) ? (pk[e >> 1] >> 16) : (pk[e >> 1] & 0xffffu);
            if (tt & 1) outp[e][(tt >> 1) & 3] |= hv << 16; else outp[e][(tt >> 1) & 3] = hv;
          }
          if ((tt & 7) == 7) {
#pragma unroll
            for (int e = 0; e < 4; ++e)
              *(u32x4*)(p.KTm + (size_t)(c0 - 512 + e) * TB + mt * 256 + t0 + (tt & 24)) = (u32x4){outp[e][0], outp[e][1], outp[e][2], outp[e][3]};
          }
        }
      }
      __syncthreads();
    }
    if (nt == 64 && wn == 0) {
#pragma unroll
      for (int i = 0; i < 4; ++i) {
        const int m = mt * 256 + wm * 128 + i * 32 + l32;
#pragma unroll
        for (int r4 = 0; r4 < 2; ++r4) {
          const int gc = 8 * r4 + 4 * hh, type = gc >> 2;
          f32x4 o;
#pragma unroll
          for (int r = 0; r < 4; ++r) {
            float g = acc[i][0][4 * r4 + r] + p.b_gate[gc + r];
            if (type & 1) g = fminf(g, 0.f) - __logf(1.f + __expf(-fabsf(g)));
            o[r] = g;
          }
          *(f32x4*)(p.gates + (size_t)m * 16 + gc) = o;
        }
      }
    }
  }
}

DI void load16(const bf16_t* src, float (&v)[16]) {
  const u32x4 a = *(const u32x4*)src, b2 = *(const u32x4*)(src + 8);
#pragma unroll
  for (int i = 0; i < 4; ++i) { v[2 * i] = bf_lo(a[i]); v[2 * i + 1] = bf_hi(a[i]); v[8 + 2 * i] = bf_lo(b2[i]); v[8 + 2 * i + 1] = bf_hi(b2[i]); }
}
DI void store16(bf16_t* dst, const float (&v)[16]) {
  u32x4 a, b2;
#pragma unroll
  for (int i = 0; i < 4; ++i) { a[i] = pk2(v[2 * i], v[2 * i + 1]); b2[i] = pk2(v[8 + 2 * i], v[8 + 2 * i + 1]); }
  *(u32x4*)dst = a; *(u32x4*)(dst + 8) = b2;
}
DI void tile_transpose_store(bf16_t* sm, const float (&v)[16], bf16_t* dstT, size_t ld, int col0, int tok0) {
  int tid = threadIdx.x; asm volatile("" : "+v"(tid));
  const int r = tid >> 2, seg = tid & 3;
#pragma unroll
  for (int i = 0; i < 16; ++i) sm[r * 66 + seg * 16 + i] = f2bf(v[i]);
  __syncthreads();
  const int col = tid >> 2, ts = (tid & 3) * 16;
  unsigned w[8];
#pragma unroll
  for (int i = 0; i < 8; ++i) w[i] = (unsigned)sm[(ts + 2 * i) * 66 + col] | ((unsigned)sm[(ts + 2 * i + 1) * 66 + col] << 16);
  u32x4* d = (u32x4*)(dstT + (size_t)(col0 + col) * ld + tok0 + ts);
  d[0] = (u32x4){w[0], w[1], w[2], w[3]};
  d[1] = (u32x4){w[4], w[5], w[6], w[7]};
  __syncthreads();
}

DI void scan_step(const Params& p, int chain, int i, float m, bool finalize, float& BL_out, float& pmax_out) {
  int tidl = threadIdx.x; asm volatile("" : "+v"(tidl));
  const int lane = tidl & 63, h = chain >> 1, dir = chain & 1;
  const int gi = (dir ? 8 : 0) + h, gf = (dir ? 12 : 4) + h;
  const int tau0 = i == 0 ? SEQ : (dir ? (32 - i) * 256 : (i - 1) * 256);
  float ig[4], B[4], a[4], pm[4];
  float run = 0.f;
#pragma unroll
  for (int r = 0; r < 4; ++r) {
    const int j = 4 * lane + r, pos = dir ? 255 - j : j;
    const float* g = p.gates + (size_t)(tau0 + pos) * 16;
    ig[r] = g[gi]; run += g[gf]; B[r] = run;
  }
  float inc = run;
#pragma unroll
  for (int o = 1; o < 64; o <<= 1) { const float t = __shfl_up(inc, o); if (lane >= o) inc += t; }
  const float excl = inc - run;
  const float BL = __shfl(inc, 63);
  float rmax = -3.0e38f;
#pragma unroll
  for (int r = 0; r < 4; ++r) { B[r] += excl; a[r] = ig[r] - B[r]; rmax = fmaxf(rmax, a[r]); pm[r] = rmax; }
  float incm = rmax;
#pragma unroll
  for (int o = 1; o < 64; o <<= 1) { const float t = __shfl_up(incm, o); if (lane >= o) incm = fmaxf(incm, t); }
  float exm = __shfl_up(incm, 1); if (lane == 0) exm = -3.0e38f;
  const float pmax_all = __shfl(incm, 63);
  BL_out = BL; pmax_out = pmax_all;
  if (finalize) {
    const float g255 = fmaxf(m, pmax_all);
    float* sc = p.scal + (size_t)(chain * NSTEP + i) * 1024;
#pragma unroll
    for (int r = 0; r < 4; ++r) {
      const int j = 4 * lane + r, pos = dir ? 255 - j : j;
      const float gj = fmaxf(m, fmaxf(exm, pm[r]));
      f32x4 o = {a[r], gj, B[r] + gj, __expf(a[r] - g255)};
      *(f32x4*)(sc + pos * 4) = o;
    }
    if (lane == 0) { p.stepsc[(chain * NSTEP + i) * 2] = m; p.stepsc[(chain * NSTEP + i) * 2 + 1] = __expf(m - g255); }
  }
}
DI void scalar_scan_block(const Params& p, int chain, float* sm) {
  const int lane = threadIdx.x & 63, wid = threadIdx.x >> 6;
  __syncthreads();
  for (int i = wid; i < NSTEP; i += 4) {
    float BL, pm; scan_step(p, chain, i, 0.f, false, BL, pm);
    if (lane == 0) { sm[i] = BL; sm[64 + i] = pm; }
  }
  __syncthreads();
  float m = 0.f;
  for (int i = 0; i < NSTEP; ++i) {
    if ((i & 3) == wid) { float BL, pm; scan_step(p, chain, i, m, true, BL, pm); }
    m = sm[i] + fmaxf(m, sm[64 + i]);
  }
  __syncthreads();
}

DI void phase_prep(const Params& p, int b, int vb, int G, unsigned char* smem) {
  bf16_t* sm = (bf16_t*)smem;
  int tid = threadIdx.x; asm volatile("" : "+v"(tid));
  const int r = tid >> 2, seg = tid & 3;
  const int nA = 33, nB = 0, nC = 0, nD = 0, nE = 0;
  const int total = 8 + nA;
  for (int t = vb; t < total; t += G) {
    if (t < 8) { scalar_scan_block(p, t, (float*)smem); continue; }
    int u = t - 8;
    if (u < nA) {
      const int mtile = u, brow = tid >> 6, c0 = (tid & 63) * 16;
      const int tau = mtile * 256 + (brow < 2 ? brow : 252 + brow);
      const int lo = mtile < 32 ? 0 : SEQ, hi = mtile < 32 ? SEQ : TB;
      float acc[16];
#pragma unroll
      for (int i = 0; i < 16; ++i) acc[i] = p.conv_b[c0 + i];
#pragma unroll
      for (int j = 0; j < 5; ++j) {
        const int t2 = tau + j - 2;
        if (t2 >= lo && t2 < hi) {
          float xv[16]; load16(p.P + (size_t)t2 * PLD + c0, xv);
#pragma unroll
          for (int i = 0; i < 16; ++i) acc[i] += xv[i] * p.conv_w[j * 1024 + c0 + i];
        }
      }
      if (c0 < 512) {
#pragma unroll
        for (int i = 0; i < 16; ++i) acc[i] = siluf(acc[i]) * 0.08838834764831845f;
        store16(p.Qm + (size_t)tau * 512 + c0, acc);
      } else {
#pragma unroll
        for (int i = 0; i < 16; ++i) acc[i] = siluf(acc[i]);
        store16(p.Km + (size_t)tau * 512 + (c0 - 512), acc);
#pragma unroll
        for (int i = 0; i < 16; ++i) p.KTm[(size_t)(c0 - 512 + i) * TB + tau] = f2bf(acc[i]);
      }
      continue;
    }
    u -= nA;
    if (u < nB) {
      const int ct = u & 15, tt = u >> 4, tau = tt * 64 + r;
      float xv[16]; load16(p.P + (size_t)tau * PLD + 1024 + ct * 64 + seg * 16, xv);
      tile_transpose_store(sm, xv, p.VTm, TB, ct * 64, tt * 64);
      continue;
    }
    u -= nB;
    if (u < nC + nD) {
      const bool isq = u < nC;
      if (!isq) u -= nC;
      const int ct = u & 15, tt = u >> 4, tau = tt * 64 + r;
      float xv[16]; load16(p.P + (size_t)tau * PLD + (isq ? 3072 : 4096) + ct * 64 + seg * 16, xv);
      float ss = 0.f;
#pragma unroll
      for (int i = 0; i < 16; ++i) ss += xv[i] * xv[i];
      ss += __shfl_xor(ss, 1); ss += __shfl_xor(ss, 2);
      const float rstd = rsqrtf(ss * (1.0f / 64.0f) + 1e-6f);
      const float* gn = (isq ? p.q_norm : p.k_norm) + seg * 16;
#pragma unroll
      for (int i = 0; i < 16; ++i) xv[i] = xv[i] * rstd * gn[i];
      if (tt < 128) {
        const int pos = seg < 2 ? (tau >> 6) : (tau & 63);
        const float* rp = p.rope + pos * 32;
#pragma unroll
        for (int i = 0; i < 16; ++i) {
          const float other = __shfl_xor(xv[i], 1);
          const float cs = rp[2 * i], sn = rp[2 * i + 1];
          xv[i] = (seg & 1) ? xv[i] * cs + other * sn : xv[i] * cs - other * sn;
        }
      }
      if (isq) {
#pragma unroll
        for (int i = 0; i < 16; ++i) xv[i] *= 0.125f * 1.4426950408889634f;
        store16(p.Qd + (size_t)tau * 1024 + ct * 64 + seg * 16, xv);
      } else {
        store16(p.Kd + (size_t)tau * 1024 + ct * 64 + seg * 16, xv);
      }
      continue;
    }
    u -= nC + nD;
    {
      const int ct = u & 15, tt = u >> 4, tau = tt * 64 + r;
      float xv[16]; load16(p.P + (size_t)tau * PLD + 5120 + ct * 64 + seg * 16, xv);
      tile_transpose_store(sm, xv, p.VTd, TB, ct * 64, tt * 64);
    }
  }
}

DI void phase_mlstm_u(const Params& p, int vb, int G, unsigned char* smem) {
  bf16_t* sV = (bf16_t*)smem;
  bf16_t* sKT = (bf16_t*)(smem + 36864);
  float* sw = (float*)(smem + 36864 + 18432);
  int tid = threadIdx.x; asm volatile("" : "+v"(tid));
  const int lane = tid & 63, wid = tid >> 6, l32 = lane & 31, hh = lane >> 5;
  for (int tt = vb; tt < 8 * (NSTEP - 1); tt += G) {
    const int chain = tt >> 5, i = tt & 31, t = chain * NSTEP + i, h = chain >> 1, dir = chain & 1;
    const int tau0 = i == 0 ? SEQ : (dir ? (32 - i) * 256 : (i - 1) * 256);
    bf16_t* dstS = p.ST + (size_t)t * (STROWS * 128);
    __syncthreads();
    sw[tid] = p.scal[((size_t)t * 256 + tid) * 4 + 3];
    f32x16 acc[4][2];
#pragma unroll
    for (int a = 0; a < 4; ++a) { acc[a][0] = zero16(); acc[a][1] = zero16(); }
    float nsum = 0.f;
    for (int st = 0; st < 4; ++st) {
      __syncthreads();
      {
        const int seg = tid & 7;
#pragma unroll
        for (int q = 0; q < 8; ++q) {
          const int e = (tid >> 3) + 32 * q;
          *(u32x4*)(sV + e * 72 + seg * 8) = *(const u32x4*)(p.VTm + (size_t)(h * 256 + e) * TB + tau0 + st * 64 + seg * 8);
        }
#pragma unroll
        for (int q = 0; q < 4; ++q) {
          const int d = (tid >> 3) + 32 * q;
          const u32x4 kv = *(const u32x4*)(p.KTm + (size_t)(h * 128 + d) * TB + tau0 + st * 64 + seg * 8);
          const float* wp = sw + st * 64 + seg * 8;
          u32x4 o;
#pragma unroll
          for (int z = 0; z < 4; ++z) o[z] = pk2(bf_lo(kv[z]) * wp[2 * z], bf_hi(kv[z]) * wp[2 * z + 1]);
          *(u32x4*)(sKT + d * 72 + seg * 8) = o;
        }
      }
      __syncthreads();
#pragma unroll
      for (int ks = 0; ks < 4; ++ks) {
        bf16x8 kf[4], vf[2];
#pragma unroll
        for (int a = 0; a < 4; ++a) kf[a] = *(const bf16x8*)(sKT + (a * 32 + l32) * 72 + ks * 16 + hh * 8);
#pragma unroll
        for (int e2 = 0; e2 < 2; ++e2) vf[e2] = *(const bf16x8*)(sV + ((wid + 4 * e2) * 32 + l32) * 72 + ks * 16 + hh * 8);
#pragma unroll
        for (int a = 0; a < 4; ++a)
#pragma unroll
          for (int e2 = 0; e2 < 2; ++e2) acc[a][e2] = MFMA32(kf[a], vf[e2], acc[a][e2]);
      }
      if (tid < 128) {
#pragma unroll 8
        for (int s = 0; s < 64; ++s) nsum += bf2f(sKT[tid * 72 + s]);
      }
    }
#pragma unroll
    for (int a = 0; a < 4; ++a)
#pragma unroll
      for (int e2 = 0; e2 < 2; ++e2) {
        const int e = (wid + 4 * e2) * 32 + l32;
#pragma unroll
        for (int i4 = 0; i4 < 4; ++i4) {
          const int d0 = a * 32 + 8 * i4 + 4 * hh;
          const f32x16& v = acc[a][e2];
          *(u32x2*)(dstS + (size_t)e * 128 + d0) = (u32x2){pk2(v[4 * i4], v[4 * i4 + 1]), pk2(v[4 * i4 + 2], v[4 * i4 + 3])};
        }
      }
    if (tid < 128) dstS[256 * 128 + tid] = f2bf(nsum);
    for (int idx = tid; idx < 31 * 128 / 2; idx += 256) ((unsigned*)(dstS + 257 * 128))[idx] = 0u;
  }
}

DI void phase_mlstm_scan(const Params& p, int vb, int G) {
  const int pairs = STROWS * 128 / 2;
  const int ntask = 8 * pairs / 256;
  for (int t = vb; t < ntask; t += G) {
    int tidl = threadIdx.x; asm volatile("" : "+v"(tidl));
    const int gidx = t * 256 + tidl;
    const int chain = gidx / pairs, e2 = gidx % pairs;
    unsigned* base = (unsigned*)(p.ST + (size_t)chain * NSTEP * (STROWS * 128)) + e2;
    unsigned u[NSTEP];
#pragma unroll
    for (int i = 0; i < NSTEP; ++i) u[i] = base[(size_t)i * pairs];
    float s0 = 0.f, s1 = 0.f;
#pragma unroll
    for (int i = 0; i < NSTEP; ++i) {
      const float dec = p.stepsc[(chain * NSTEP + i) * 2 + 1];
      base[(size_t)i * pairs] = pk2(s0, s1);
      s0 = dec * s0 + bf_lo(u[i]); s1 = dec * s1 + bf_hi(u[i]);
    }
  }
}

DI void mlstm_out_task(const Params& p, int task, unsigned char* smem) {
  const int half = task & 1, c = (task >> 1) & 31, h = task >> 6;
  bf16_t* sK = (bf16_t*)smem;
  bf16_t* sV = (bf16_t*)(smem + 17408);
  float* sA = (float*)(smem + 17408 + 36864);
  int tid = threadIdx.x; asm volatile("" : "+v"(tid));
  const int lane = tid & 63, wid = tid >> 6, l32 = lane & 31, hh = lane >> 5;
  const int qi = half * 4 + wid, pq = qi * 32 + l32, tq = c * 256 + pq;
  bf16x8 qf[8];
#pragma unroll
  for (int ks = 0; ks < 8; ++ks) qf[ks] = *(const bf16x8*)(p.Qm + (size_t)tq * 512 + h * 128 + ks * 16 + hh * 8);
  bf16_t* hrow = p.hA + (size_t)tq * 1024 + h * 256;
  f32x16 num[8];
#pragma unroll 1
  for (int dir = 0; dir < 2; ++dir) {
    const int chain = h * 2 + dir, i = dir ? 32 - c : c + 1, sbase = chain * NSTEP + i;
    const float* sc = p.scal + (size_t)sbase * 1024;
    const float m_prev = p.stepsc[sbase * 2];
    const float g_q = sc[pq * 4 + 1], mj_q = sc[pq * 4 + 2];
    __syncthreads();
    sA[tid] = sc[tid * 4];
    f32x16 dent = zero16();
#pragma unroll
    for (int eb = 0; eb < 8; ++eb) num[eb] = zero16();
    float rs = 0.f;
    const int st_lo = dir == 0 ? 0 : half * 2, st_hi = dir == 0 ? half * 2 + 1 : 3;
    u32x4 rk[4], rv[8];
    {
      const int seg = tid & 15, sg = tid & 7;
#pragma unroll
      for (int q = 0; q < 4; ++q) rk[q] = *(const u32x4*)(p.Km + (size_t)(c * 256 + st_lo * 64 + (tid >> 4) + 16 * q) * 512 + h * 128 + seg * 8);
#pragma unroll
      for (int q = 0; q < 8; ++q) rv[q] = *(const u32x4*)(p.VTm + (size_t)(h * 256 + (tid >> 3) + 32 * q) * TB + c * 256 + st_lo * 64 + sg * 8);
    }
#pragma unroll 1
    for (int st = st_lo; st <= st_hi; ++st) {
      __syncthreads();
      {
        const int seg = tid & 15, sg = tid & 7;
#pragma unroll
        for (int q = 0; q < 4; ++q) *(u32x4*)(sK + ((tid >> 4) + 16 * q) * 136 + seg * 8) = rk[q];
#pragma unroll
        for (int q = 0; q < 8; ++q) *(u32x4*)(sV + ((tid >> 3) + 32 * q) * 72 + sg * 8) = rv[q];
      }
      __syncthreads();
      {
        const int sn = st < st_hi ? st + 1 : st;
        const int seg = tid & 15, sg = tid & 7;
#pragma unroll
        for (int q = 0; q < 4; ++q) rk[q] = *(const u32x4*)(p.Km + (size_t)(c * 256 + sn * 64 + (tid >> 4) + 16 * q) * 512 + h * 128 + seg * 8);
#pragma unroll
        for (int q = 0; q < 8; ++q) rv[q] = *(const u32x4*)(p.VTm + (size_t)(h * 256 + (tid >> 3) + 32 * q) * TB + c * 256 + sn * 64 + sg * 8);
      }
#pragma unroll 1
      for (int sub = 0; sub < 2; ++sub) {
        const int ki = st * 2 + sub;
        const bool need = dir == 0 ? ki <= qi : ki >= qi;
        if (!need) continue;
        f32x16 S = zero16();
#pragma unroll
        for (int ks = 0; ks < 8; ++ks) {
          const bf16x8 a = *(const bf16x8*)(sK + (sub * 32 + l32) * 136 + ks * 16 + hh * 8);
          S = MFMA32(a, qf[ks], S);
        }
#pragma unroll
        for (int i4 = 0; i4 < 4; ++i4) {
          const f32x4 av = *(const f32x4*)(sA + ki * 32 + 8 * i4 + 4 * hh);
#pragma unroll
          for (int r = 0; r < 4; ++r) {
            const int sp = ki * 32 + 8 * i4 + 4 * hh + r;
            const bool ok = dir == 0 ? sp <= pq : sp >= pq;
            const float dm = ok ? __expf(av[r] - g_q) : 0.f;
            const float v = S[4 * i4 + r] * dm;
            S[4 * i4 + r] = v; rs += v;
          }
        }
        const bf16x8 pf0 = pack8(S, 0), pf1 = pack8(S, 1);
#pragma unroll
        for (int eb = 0; eb < 8; ++eb) {
          const bf16_t* vr = sV + (eb * 32 + l32) * 72 + sub * 32 + 4 * hh;
          const bf16x8 v0 = cat4(*(const u32x2*)(vr), *(const u32x2*)(vr + 8));
          const bf16x8 v1 = cat4(*(const u32x2*)(vr + 16), *(const u32x2*)(vr + 24));
          num[eb] = MFMA32(v0, pf0, num[eb]);
          num[eb] = MFMA32(v1, pf1, num[eb]);
        }
      }
    }
    const float inter = __expf(m_prev - g_q);
    const bf16_t* Cst = p.ST + (size_t)sbase * (STROWS * 128);
    {
      bf16x8 cf[2][8];
#pragma unroll
      for (int ks = 0; ks < 8; ++ks) cf[0][ks] = *(const bf16x8*)(Cst + (size_t)l32 * 128 + ks * 16 + hh * 8);
#pragma unroll
      for (int eb = 0; eb < 9; ++eb) {
        if (eb < 8) {
#pragma unroll
          for (int ks = 0; ks < 8; ++ks) cf[(eb + 1) & 1][ks] = *(const bf16x8*)(Cst + (size_t)((eb + 1) * 32 + l32) * 128 + ks * 16 + hh * 8);
        }
        f32x16 tmp = zero16();
#pragma unroll
        for (int ks = 0; ks < 8; ++ks) tmp = MFMA32(cf[eb & 1][ks], qf[ks], tmp);
        if (eb < 8) {
#pragma unroll
          for (int r = 0; r < 16; ++r) num[eb][r] += inter * tmp[r];
        } else {
          dent = tmp;
        }
        __builtin_amdgcn_sched_barrier(0);
      }
    }
    rs += __shfl_xor(rs, 32);
    const float dn = inter * __shfl(dent[0], l32);
    const float den = rs + dn;
    const float inv = 1.0f / fmaxf(fabsf(den), __expf(-mj_q));
    if (dir == 0) {
#pragma unroll
      for (int eb = 0; eb < 8; ++eb)
#pragma unroll
        for (int i4 = 0; i4 < 4; ++i4) {
          const f32x16& v = num[eb];
          *(u32x2*)(hrow + eb * 32 + 8 * i4 + 4 * hh) = (u32x2){pk2(v[4 * i4] * inv, v[4 * i4 + 1] * inv), pk2(v[4 * i4 + 2] * inv, v[4 * i4 + 3] * inv)};
        }
    } else {
#pragma unroll
      for (int eb = 0; eb < 8; ++eb)
#pragma unroll
        for (int i4 = 0; i4 < 4; ++i4) {
          const u32x2 st2 = *(const u32x2*)(hrow + eb * 32 + 8 * i4 + 4 * hh);
          num[eb][4 * i4 + 0] = bf_lo(st2[0]) + num[eb][4 * i4 + 0] * inv;
          num[eb][4 * i4 + 1] = bf_hi(st2[0]) + num[eb][4 * i4 + 1] * inv;
          num[eb][4 * i4 + 2] = bf_lo(st2[1]) + num[eb][4 * i4 + 2] * inv;
          num[eb][4 * i4 + 3] = bf_hi(st2[1]) + num[eb][4 * i4 + 3] * inv;
          if (i4 == 3) asm volatile("" ::: "memory");
        }
    }
  }
  float ss = 0.f;
#pragma unroll
  for (int eb = 0; eb < 8; ++eb)
#pragma unroll
    for (int r = 0; r < 16; ++r) ss += num[eb][r] * num[eb][r];
  ss += __shfl_xor(ss, 32);
  const float rstd = rsqrtf(ss * (1.0f / 256.0f) + 1e-6f);
  const bf16_t* morow = p.P + (size_t)tq * PLD + 2048 + h * 256;
#pragma unroll
  for (int eb = 0; eb < 8; ++eb)
#pragma unroll
    for (int i4 = 0; i4 < 4; ++i4) {
      const int e0 = eb * 32 + 8 * i4 + 4 * hh;
      const f32x4 gn = *(const f32x4*)(p.mlstm_norm + h * 256 + e0);
      const u32x2 mo = *(const u32x2*)(morow + e0);
      const float o0 = num[eb][4 * i4 + 0] * rstd * gn[0] * sigmf(bf_lo(mo[0]));
      const float o1 = num[eb][4 * i4 + 1] * rstd * gn[1] * sigmf(bf_hi(mo[0]));
      const float o2 = num[eb][4 * i4 + 2] * rstd * gn[2] * sigmf(bf_lo(mo[1]));
      const float o3 = num[eb][4 * i4 + 3] * rstd * gn[3] * sigmf(bf_hi(mo[1]));
      *(u32x2*)(hrow + e0) = (u32x2){pk2(o0, o1), pk2(o2, o3)};
      if ((i4 & 1) == 1) asm volatile("" ::: "memory");
    }
}

DI void attn_task(const Params& p, int task, unsigned char* smem) {
  const int h = task >> 6, qb = task & 63;
  bf16_t* sK = (bf16_t*)smem;
  int tid = threadIdx.x; asm volatile("" : "+v"(tid));
  const int lane = tid & 63, wid = tid >> 6, l32 = lane & 31, hh = lane >> 5;
  const int tq = qb * 128 + wid * 32 + l32;
  float lam, M2;
  {
    const float* lv = p.lam_vecs;
    float a = lv[lane] * lv[64 + lane], b2 = lv[128 + lane] * lv[192 + lane];
    float gq = fabsf(p.q_norm[lane]), gk = fabsf(p.k_norm[lane]);
#pragma unroll
    for (int o = 32; o >= 1; o >>= 1) { a += __shfl_xor(a, o); b2 += __shfl_xor(b2, o); gq = fmaxf(gq, __shfl_xor(gq, o)); gk = fmaxf(gk, __shfl_xor(gk, o)); }
    lam = __expf(a) - __expf(b2) + 0.2f;
    M2 = 8.0f * 1.4426950408889634f * gq * gk;
  }
  bf16x8 qf[2][4];
#pragma unroll
  for (int mp = 0; mp < 2; ++mp)
#pragma unroll
    for (int s = 0; s < 4; ++s) qf[mp][s] = *(const bf16x8*)(p.Qd + (size_t)tq * 1024 + h * 128 + mp * 64 + s * 16 + hh * 8);
  f32x16 O[2][4];
#pragma unroll
  for (int mp = 0; mp < 2; ++mp)
#pragma unroll
    for (int eb = 0; eb < 4; ++eb) O[mp][eb] = zero16();
  float ls0 = 0.f, ls1 = 0.f;
  f32x16 minit;
#pragma unroll
  for (int r = 0; r < 16; ++r) minit[r] = -M2;
  const int kr = tid >> 4, kseg = tid & 15, vr = tid >> 3, vseg = tid & 7;
  const bf16_t* kg = p.Kd + (size_t)kr * 1024 + h * 128 + kseg * 8;
  const bf16_t* vg = p.VTd + (size_t)(h * 128 + vr) * TB + vseg * 8;
  constexpr int ABUF = 64 * 136 + 128 * 72;
  u32x4 rg[8];
#define A_LOAD(Q, KT) do { if ((Q) < 4) rg[Q] = *(const u32x4*)(kg + (size_t)((KT) * 64 + 16 * (Q)) * 1024); \
                           else rg[Q] = *(const u32x4*)(vg + (size_t)(32 * ((Q) - 4)) * TB + (KT) * 64); } while (0)
#define A_STORE(Q, BASE) do { if ((Q) < 4) *(u32x4*)((BASE) + (kr + 16 * (Q)) * 136 + kseg * 8) = rg[Q]; \
                              else *(u32x4*)((BASE) + 64 * 136 + (vr + 32 * ((Q) - 4)) * 72 + vseg * 8) = rg[Q]; } while (0)
  const int NKT = TB / 64;
  __syncthreads();
#pragma unroll
  for (int q = 0; q < 8; ++q) A_LOAD(q, 0);
#pragma unroll
  for (int q = 0; q < 8; ++q) A_STORE(q, sK);
#pragma unroll
  for (int q = 0; q < 8; ++q) A_LOAD(q, 1);
  __syncthreads();
#pragma unroll 1
  for (int kt = 0; kt < NKT; ++kt) {
    const bf16_t* cK = sK + (kt & 1) * ABUF; const bf16_t* cV = cK + 64 * 136;
    bf16_t* so = sK + ((kt & 1) ^ 1) * ABUF;
    const int k2 = kt + 2 < NKT ? kt + 2 : NKT - 1;
#pragma unroll
    for (int sub = 0; sub < 2; ++sub) {
      bf16x8 pf[2][2];
#pragma unroll
      for (int mp = 0; mp < 2; ++mp) {
        f32x16 S = minit;
#pragma unroll
        for (int s = 0; s < 4; ++s) {
          const bf16x8 a = *(const bf16x8*)(cK + (sub * 32 + l32) * 136 + mp * 64 + s * 16 + hh * 8);
          S = MFMA32(a, qf[mp][s], S);
        }
        float l = 0.f;
#pragma unroll
        for (int r = 0; r < 16; ++r) { S[r] = __builtin_amdgcn_exp2f(S[r]); l += S[r]; }
        if (mp == 0) ls0 += l; else ls1 += l;
        pf[mp][0] = pack8(S, 0); pf[mp][1] = pack8(S, 1);
      }
#pragma unroll
      for (int q = sub * 4; q < sub * 4 + 4; ++q) { A_STORE(q, so); A_LOAD(q, k2); }
#pragma unroll
      for (int eb = 0; eb < 4; ++eb) {
        const bf16_t* vrp = cV + (eb * 32 + l32) * 72 + sub * 32 + 4 * hh;
        const bf16x8 v0 = cat4(*(const u32x2*)(vrp), *(const u32x2*)(vrp + 8));
        const bf16x8 v1 = cat4(*(const u32x2*)(vrp + 16), *(const u32x2*)(vrp + 24));
        O[0][eb] = MFMA32(v0, pf[0][0], O[0][eb]);
        O[1][eb] = MFMA32(v0, pf[1][0], O[1][eb]);
        O[0][eb] = MFMA32(v1, pf[0][1], O[0][eb]);
        O[1][eb] = MFMA32(v1, pf[1][1], O[1][eb]);
      }
    }
    __syncthreads();
  }
#undef A_LOAD
#undef A_STORE
  ls0 += __shfl_xor(ls0, 32); ls1 += __shfl_xor(ls1, 32);
  const float i0 = 1.0f / ls0, i1 = lam / ls1;
  float ss = 0.f;
#pragma unroll
  for (int eb = 0; eb < 4; ++eb)
#pragma unroll
    for (int r = 0; r < 16; ++r) { const float o = O[0][eb][r] * i0 - O[1][eb][r] * i1; O[0][eb][r] = o; ss += o * o; }
  ss += __shfl_xor(ss, 32);
  const float rstd = rsqrtf(ss * (1.0f / 128.0f) + 1e-6f) * 0.8f;
  bf16_t* orow = p.hB + (size_t)tq * 1024 + h * 128;
#pragma unroll
  for (int eb = 0; eb < 4; ++eb)
#pragma unroll
    for (int i4 = 0; i4 < 4; ++i4) {
      const int e0 = eb * 32 + 8 * i4 + 4 * hh;
      const f32x4 gn = *(const f32x4*)(p.diff_norm + e0);
      const f32x16& o = O[0][eb];
      *(u32x2*)(orow + e0) = (u32x2){pk2(o[4 * i4] * rstd * gn[0], o[4 * i4 + 1] * rstd * gn[1]), pk2(o[4 * i4 + 2] * rstd * gn[2], o[4 * i4 + 3] * rstd * gn[3])};
    }
}

DI void phase_merge(const Params& p, int vb, int G, unsigned char* smem) {
  EPI_COORDS(4);
  for (int t = vb; t < 32 * 8; t += G) {
    int mt, nt; tile_map(t, 8, 4, mt, nt);
    f32x16 acc[4][2];
    acc_zero(acc);
    gemm_kloop<4>(p.hA + (size_t)mt * 256 * DM, DM, p.WaT + (size_t)nt * 128 * DM, DM, DM, acc, smem);
#pragma unroll
    for (int i = 0; i < 4; ++i) {
      const int m = mt * 256 + wm * 128 + i * 32 + l32;
#pragma unroll
      for (int j = 0; j < 2; ++j)
#pragma unroll
        for (int r4 = 0; r4 < 4; ++r4) {
          const int n = nt * 128 + wn * 64 + j * 32 + 8 * r4 + 4 * hh;
          const u32x2 g = *(const u32x2*)(p.P + (size_t)m * PLD + 6144 + n);
          *(u32x2*)(p.y + (size_t)m * DM + n) = (u32x2){pk2(sigmf(bf_lo(g[0])) * acc[i][j][4 * r4 + 0], sigmf(bf_hi(g[0])) * acc[i][j][4 * r4 + 1]),
                                                        pk2(sigmf(bf_lo(g[1])) * acc[i][j][4 * r4 + 2], sigmf(bf_hi(g[1])) * acc[i][j][4 * r4 + 3])};
        }
    }
    acc_zero(acc);
    gemm_kloop<4>(p.hB + (size_t)mt * 256 * DM, DM, p.WbT + (size_t)nt * 128 * DM, DM, DM, acc, smem);
#pragma unroll
    for (int i = 0; i < 4; ++i) {
      const int m = mt * 256 + wm * 128 + i * 32 + l32;
#pragma unroll
      for (int j = 0; j < 2; ++j)
#pragma unroll
        for (int r4 = 0; r4 < 4; ++r4) {
          const int n = nt * 128 + wn * 64 + j * 32 + 8 * r4 + 4 * hh;
          const u32x2 g = *(const u32x2*)(p.P + (size_t)m * PLD + 7168 + n);
          const u32x2 y0 = *(const u32x2*)(p.y + (size_t)m * DM + n);
          const float o0 = bf_lo(y0[0]) + sigmf(bf_lo(g[0])) * acc[i][j][4 * r4 + 0], o1 = bf_hi(y0[0]) + sigmf(bf_hi(g[0])) * acc[i][j][4 * r4 + 1];
          const float o2 = bf_lo(y0[1]) + sigmf(bf_lo(g[1])) * acc[i][j][4 * r4 + 2], o3 = bf_hi(y0[1]) + sigmf(bf_hi(g[1])) * acc[i][j][4 * r4 + 3];
          *(u32x2*)(p.y + (size_t)m * DM + n) = (u32x2){pk2(o0, o1), pk2(o2, o3)};
        }
    }
  }
}

DI void phase_outproj(const Params& p, int b, int vb, int G, unsigned char* smem) {
  EPI_COORDS(4);
  for (int t = vb; t < 32 * 8; t += G) {
    int mt, nt; tile_map(t, 8, 4, mt, nt);
    f32x16 acc[4][2]; acc_zero(acc);
    gemm_kloop<4>(p.y + (size_t)mt * 256 * DM, DM, p.WoT + (size_t)nt * 128 * DM, DM, DM, acc, smem);
#pragma unroll
    for (int i = 0; i < 4; ++i) {
      const int m = mt * 256 + wm * 128 + i * 32 + l32;
      const size_t row = (size_t)(b * SEQ + m) * DM;
#pragma unroll
      for (int j = 0; j < 2; ++j)
#pragma unroll
        for (int r4 = 0; r4 < 4; ++r4) {
          const int n = nt * 128 + wn * 64 + j * 32 + 8 * r4 + 4 * hh;
          const f32x4 xv = *(const f32x4*)(p.x + row + n), g1 = *(const f32x4*)(p.mod + b * 6144 + 2048 + n);
          f32x4 o;
#pragma unroll
          for (int r = 0; r < 4; ++r) o[r] = xv[r] + g1[r] * acc[i][j][4 * r4 + r];
          *(f32x4*)(p.out + row + n) = o;
        }
    }
  }
}

template <int PROBE>
DI void phase_ffn_in(const Params& p, int vb, int G, unsigned char* smem) {
  EPI_COORDS(4);
  for (int t = vb; t < 128 * 44; t += G) {
    int mt, nt; tile_map(t, 44, 4, mt, nt);
    f32x16 acc[4][2]; acc_zero(acc);
    gemm_kloop<4>(p.xn2 + (size_t)(PROBE == 1 ? 0 : mt) * 256 * DM, DM, p.WfiT + (size_t)(PROBE == 1 ? 0 : nt) * 128 * DM, DM, DM, acc, smem);
#pragma unroll
    for (int i = 0; i < 4; ++i) {
      const int m = mt * 256 + wm * 128 + i * 32 + l32;
#pragma unroll
      for (int r4 = 0; r4 < 4; ++r4) {
        const int hc = (nt * 2 + wn) * 32 + 8 * r4 + 4 * hh;
        float o[4];
#pragma unroll
        for (int r = 0; r < 4; ++r) o[r] = siluf(acc[i][0][4 * r4 + r]) * acc[i][1][4 * r4 + r];
        bf16_t* hdst = PROBE ? p.hid + (size_t)NB * SEQ * FH + (size_t)(m & 8191) * FH : p.hid + (size_t)m * FH;
        *(u32x2*)(hdst + hc) = (u32x2){pk2(o[0], o[1]), pk2(o[2], o[3])};
      }
    }
  }
}

DI void phase_ffn_out(const Params& p, int vb, int G, unsigned char* smem) {
  EPI_COORDS(8);
  for (int t = vb; t < 128 * 4; t += G) {
    int mt, nt; tile_map(t, 4, 8, mt, nt);
    f32x16 acc[4][4]; acc_zero(acc);
    gemm_kloop<8>(p.hid + (size_t)mt * 256 * FH, FH, p.WfoT + (size_t)nt * 256 * FH, FH, FH, acc, smem);
#pragma unroll
    for (int i = 0; i < 4; ++i) {
      const int m = mt * 256 + wm * 128 + i * 32 + l32;
      const int b = m >> 13;
#pragma unroll
      for (int j = 0; j < 4; ++j)
#pragma unroll
        for (int r4 = 0; r4 < 4; ++r4) {
          const int n = nt * 256 + wn * 128 + j * 32 + 8 * r4 + 4 * hh;
          float* op = p.out + (size_t)m * DM + n;
          const f32x4 xv = *(const f32x4*)op, g2 = *(const f32x4*)(p.mod + b * 6144 + 5120 + n);
          f32x4 o;
#pragma unroll
          for (int r = 0; r < 4; ++r) o[r] = xv[r] + g2[r] * acc[i][j][4 * r4 + r];
          *(f32x4*)op = o;
        }
    }
  }
}

#define XB_TMO      128
#define XB_XCNT(j)  (256  + 64 * (j))
#define XB_XSUB(j)  (1280 + 64 * (j))
#define XB_XGEN(j)  (2304 + 64 * (j))
#define XB_TOP      3328
#define XB_TOPGEN   3392
#define XCD_BAR_WORDS 3456
#define XB_SPIN_CAP (1u << 22)
#define LAS __attribute__((address_space(3)))
DI unsigned xb_ld(unsigned* p) { return __hip_atomic_load(p, __ATOMIC_RELAXED, __HIP_MEMORY_SCOPE_AGENT); }
DI unsigned xb_add(unsigned* p, unsigned v) { return __hip_atomic_fetch_add(p, v, __ATOMIC_RELAXED, __HIP_MEMORY_SCOPE_AGENT); }
DI unsigned xb_xcc_id() { return (unsigned)__builtin_amdgcn_s_getreg((3 << 11) | 20) & 0xFu; }
#define XB_SPIN(cond, bar) do { unsigned _sp = 0; while (cond) { __builtin_amdgcn_s_sleep(1); \
    if ((++_sp & 255u) == 0u) { if (xb_ld(&(bar)[XB_TMO])) break; if (_sp > XB_SPIN_CAP) { atomicAdd(&(bar)[XB_TMO], 1u); break; } } } } while (0)
struct XcdBarrier { unsigned* bar; unsigned x; volatile LAS unsigned* st; };
DI XcdBarrier xcd_barrier_post(unsigned* bar, volatile LAS unsigned* st) {
  XcdBarrier b; b.bar = bar; b.x = xb_xcc_id(); b.st = st;
  if (threadIdx.x == 0) st[2] = xb_add(&bar[XB_XCNT(b.x)], 1u);
  return b;
}
DI void xcd_barrier_complete(unsigned* bar, unsigned x, unsigned& nloc, unsigned& nx) {
  const unsigned G = gridDim.x * gridDim.y * gridDim.z;
  unsigned sum, cnt, mine, sp = 0u;
  for (;;) {
    sum = 0u; cnt = 0u; mine = 0u;
#pragma unroll
    for (unsigned j = 0; j < 16; ++j) { const unsigned c = xb_ld(&bar[XB_XCNT(j)]); sum += c; cnt += (c > 0u) ? 1u : 0u; mine = (j == x) ? c : mine; }
    if (sum == G) break;
    __builtin_amdgcn_s_sleep(1);
    if ((++sp & 255u) == 0u) { if (xb_ld(&bar[XB_TMO])) break; if (sp > XB_SPIN_CAP) { atomicAdd(&bar[XB_TMO], 1u); break; } }
  }
  nloc = mine > 0u ? mine : 1u; nx = cnt > 0u ? cnt : 1u;
}
DI void xcd_barrier(const XcdBarrier& b) {
  asm volatile("s_waitcnt vmcnt(0)" ::: "memory");
  __syncthreads();
  if (threadIdx.x == 0) {
    unsigned* bar = b.bar;
    __builtin_amdgcn_s_waitcnt(0);
    unsigned nloc = b.st[0], nx = b.st[1];
    if (nloc == 0u) { xcd_barrier_complete(bar, b.x, nloc, nx); b.st[0] = nloc; b.st[1] = nx; }
    const unsigned old = xb_add(&bar[XB_XSUB(b.x)], 1u);
    const unsigned gen = old / nloc;
    if (old + 1u == (gen + 1u) * nloc) {
      __builtin_amdgcn_fence(__ATOMIC_RELEASE, "agent");
      asm volatile("s_waitcnt vmcnt(0)" ::: "memory");
      const unsigned og = xb_add(&bar[XB_TOP], 1u);
      const unsigned tg = og / nx;
      if (og + 1u == (tg + 1u) * nx) xb_add(&bar[XB_TOPGEN], 1u);
      else XB_SPIN(xb_ld(&bar[XB_TOPGEN]) == tg, bar);
      __builtin_amdgcn_fence(__ATOMIC_ACQUIRE, "agent");
      xb_add(&bar[XB_XGEN(b.x)], 1u);
      asm volatile("s_waitcnt vmcnt(0)" ::: "memory");
    } else {
      XB_SPIN(xb_ld(&bar[XB_XGEN(b.x)]) == gen, bar);
      __builtin_amdgcn_fence(__ATOMIC_ACQUIRE, "agent");
      asm volatile("s_waitcnt vmcnt(0)" ::: "memory");
    }
  }
  __syncthreads();
}

#ifndef PHMASK
#define PHMASK 0xFFFF
#endif
#define PH(n) ((PHMASK >> (n)) & 1)
#ifndef REPMASK
#define REPMASK 0
#endif
#define NREP(n) (1 + ((REPMASK >> (n)) & 1))
#define GSYNC() do { xcd_barrier(xb); if ((REPMASK >> 15) & 1) xcd_barrier(xb); } while (0)
__global__ void __launch_bounds__(256, 1) hybrid_block_megakernel(Params p) {
  cg::grid_group grid = cg::this_grid();
  __shared__ __attribute__((aligned(16))) unsigned char smem[SMEM_BYTES];
  const int G = gridDim.x, bid = blockIdx.x;
  int vb = bid;
  const int wid = threadIdx.x >> 6;
  __shared__ __attribute__((aligned(16))) unsigned xb_words[4];
  if (threadIdx.x < 4) xb_words[threadIdx.x] = 0u;
  __syncthreads();
  const XcdBarrier xb = xcd_barrier_post(p.bar, (volatile LAS unsigned*)xb_words);

  if (PH(0)) phase0(p, vb, G, smem);
  grid.sync();
  GSYNC();
  if (threadIdx.x == 0) {
    bool even = (G % 8) == 0 && xb.x < 8u;
    for (unsigned j = 0; j < 16; ++j) { const unsigned cnt = xb_ld(&p.bar[XB_XCNT(j)]); if (cnt != (j < 8u ? (unsigned)(G / 8) : 0u)) even = false; }
    xb_words[3] = even ? 1u : 0u;
  }
  __syncthreads();
  if (xb_words[3]) vb = (int)xb.x * (G / 8) + (int)xb_words[2];
  for (int t = vb; t < NB * TB / 8; t += G) {
    const int R0 = t * 8 + wid * 2;
    const float* src[2]; const float* md[2];
#pragma unroll
    for (int z = 0; z < 2; ++z) {
      const int R = R0 + z, b = R / TB, tau = R % TB;
      src[z] = tau < SEQ ? p.x + (size_t)(b * SEQ + tau) * DM : p.ctx + (size_t)(b * CTXL + tau - SEQ) * DM;
      md[z] = p.mod + (tau < SEQ ? b : 4) * 6144;
    }
    norm_row2(src[0], src[1], p.norm1, md[0], md[0] + 1024, md[1], md[1] + 1024, p.xn + (size_t)R0 * DM, p.xn + (size_t)(R0 + 1) * DM);
  }
  GSYNC();
  for (int b = -1; b < NB; ++b) {
   if (b >= 0) {
    for (int rep = 0; rep < NREP(2); ++rep) {
      if (PH(2)) phase_prep(p, b, vb, G, smem);
      GSYNC();
    }
    for (int rep = 0; rep < NREP(3); ++rep) {
      if (PH(3)) phase_mlstm_u(p, vb, G, smem);
      GSYNC();
      if (PH(4)) phase_mlstm_scan(p, vb, G);
      GSYNC();
    }
    for (int rep = 0; rep < NREP(5); ++rep) {
      for (int t = vb; t < 512; t += G) { if (PH(5)) attn_task(p, t, smem); }
    }
    for (int rep = 0; rep < NREP(6); ++rep) {
      for (int t = vb; t < 256; t += G) { if (PH(6)) mlstm_out_task(p, t, smem); }
    }
    GSYNC();
    for (int rep = 0; rep < NREP(7); ++rep) {
      if (PH(7)) phase_merge(p, vb, G, smem);
      GSYNC();
      if (PH(8)) phase_outproj(p, b, vb, G, smem);
    }
   }
    if (b + 1 < NB && PH(1)) phase_inproj(p, b + 1, vb, G, smem);
    GSYNC();
  }
  for (int t = vb; t < NB * SEQ / 8; t += G) {
    const int R0 = t * 8 + wid * 2, b = R0 >> 13;
    const float* md = p.mod + b * 6144;
    norm_row2(p.out + (size_t)R0 * DM, p.out + (size_t)(R0 + 1) * DM, p.norm2, md + 3072, md + 4096, md + 3072, md + 4096, p.xn2 + (size_t)R0 * DM, p.xn2 + (size_t)(R0 + 1) * DM);
  }
  GSYNC();
  for (int rep = 0; rep < NREP(9); ++rep) {
    if (PH(9)) phase_ffn_in<0>(p, vb, G, smem);
    GSYNC();
  }

  if (PH(10)) phase_ffn_out(p, vb, G, smem);
}

extern "C" void kernel_launch(void* const* d_in, const int* in_sizes, int n_in, void* d_out, int out_size, void* d_ws, size_t ws_size,
                              hipStream_t stream) {
  static int grid_blocks = 0;
  if (!grid_blocks) {
    int dev = 0, cus = 0, per_cu = 0;
    (void)hipGetDevice(&dev);
    (void)hipDeviceGetAttribute(&cus, hipDeviceAttributeMultiprocessorCount, dev);
    (void)hipOccupancyMaxActiveBlocksPerMultiprocessor(&per_cu, hybrid_block_megakernel, 256, 0);
    if (per_cu > 1) per_cu = 1;
    grid_blocks = cus * per_cu;
  }
  Params p{};
  const float* const* in = (const float* const*)d_in;
  p.x = in[0]; p.c = in[1]; p.ctx = in[2]; p.c_ctx = in[3]; p.w_mod = in[4]; p.b_mod = in[5]; p.norm1 = in[6]; p.norm2 = in[7];
  p.w_in = in[8]; p.b_gate = in[9]; p.conv_w = in[10]; p.conv_b = in[11]; p.mlstm_norm = in[12]; p.q_norm = in[13]; p.k_norm = in[14];
  p.lam_vecs = in[15]; p.diff_norm = in[16]; p.w_a = in[17]; p.w_b = in[18]; p.w_out = in[19]; p.w_ffn_in = in[20]; p.w_ffn_out = in[21];
  p.out = (float*)d_out;
  unsigned char* ws = (unsigned char*)d_ws;
  size_t off = 0;
  auto take = [&](size_t bytes) { unsigned char* r = ws + off; off += (bytes + 255) & ~(size_t)255; return r; };
  p.bar = (unsigned*)take((size_t)XCD_BAR_WORDS * 4);
  (void)hipMemsetAsync(p.bar, 0, (size_t)XCD_BAR_WORDS * 4, stream);
  p.WinT = (bf16_t*)take((size_t)NWIN * 1024 * 2);
  p.WaT = (bf16_t*)take((size_t)1024 * 1024 * 2);
  p.WbT = (bf16_t*)take((size_t)1024 * 1024 * 2);
  p.WoT = (bf16_t*)take((size_t)1024 * 1024 * 2);
  p.WfiT = (bf16_t*)take((size_t)2 * FH * 1024 * 2);
  p.WfoT = (bf16_t*)take((size_t)1024 * FH * 2);
  p.mod = (float*)take((size_t)5 * 6144 * 4);
  p.rope = (float*)take((size_t)128 * 16 * 2 * 4);
  p.xn = (bf16_t*)take((size_t)NB * TB * DM * 2);
  const size_t r0 = off;
  p.P = (bf16_t*)take((size_t)TB * PLD * 2);
  p.gates = (float*)take((size_t)TB * 16 * 4);
  p.Qm = (bf16_t*)take((size_t)TB * 512 * 2);
  p.Km = (bf16_t*)take((size_t)TB * 512 * 2);
  p.KTm = (bf16_t*)take((size_t)512 * TB * 2);
  p.VTm = (bf16_t*)take((size_t)1024 * TB * 2);
  p.Qd = (bf16_t*)take((size_t)SEQ * 1024 * 2);
  p.Kd = (bf16_t*)take((size_t)TB * 1024 * 2);
  p.VTd = (bf16_t*)take((size_t)1024 * TB * 2);
  p.scal = (float*)take((size_t)8 * NSTEP * 256 * 4 * 4);
  p.stepsc = (float*)take((size_t)8 * NSTEP * 2 * 4);
  p.ST = (bf16_t*)take((size_t)8 * NSTEP * STROWS * 128 * 2);
  p.hA = (bf16_t*)take((size_t)SEQ * 1024 * 2);
  p.hB = (bf16_t*)take((size_t)SEQ * 1024 * 2);
  p.y = (bf16_t*)take((size_t)SEQ * 1024 * 2);
  p.xn2 = (bf16_t*)(ws + r0);
  p.hid = (bf16_t*)(ws + r0 + (size_t)NB * SEQ * DM * 2);
  if (off > ws_size || r0 + (size_t)NB * SEQ * DM * 2 + (size_t)NB * SEQ * FH * 2 > ws_size) fprintf(stderr, "workspace too small: need %zu have %zu\n", off, ws_size);
  void* args[] = {&p};
  hipError_t e = hipLaunchCooperativeKernel((void*)hybrid_block_megakernel, dim3(grid_blocks), dim3(256), args, 0, stream);
  if (e != hipSuccess) fprintf(stderr, "cooperative launch failed: %s (grid %d)\n", hipGetErrorString(e), grid_blocks);
}
```
